# Optimizing an MI355X kernel written in HIP

```python
import jax, jax.numpy as jnp
from jax import lax
import numpy as np

D_MODEL = 1024
BATCH = 4
SEQ = 8192
DEPTH = 4

N_MIXERS = 2
N_RG_LAYERS = (DEPTH + 1) // 2
N_NSA_LAYERS = DEPTH // 2
RMS_EPS = 1e-6
D_FF = 4 * D_MODEL
D_RNN = D_MODEL
RG_BLOCKS = 4
RG_BLOCK_W = D_RNN // RG_BLOCKS
CONV_W = 4
RG_C = 8.0
N_HEADS = 16
HEAD_DIM = D_MODEL // N_HEADS
N_KV_GROUPS = 4
HEADS_PER_GROUP = N_HEADS // N_KV_GROUPS
CMP_LEN = 32
CMP_STRIDE = 16
CMP_RATIO = CMP_LEN // CMP_STRIDE
SLC_LEN = 64
N_SELECT = 16
WINDOW = 512
Q_BLOCK = 128
Q_COLS = N_HEADS * HEAD_DIM
KV_COLS = N_KV_GROUPS * HEAD_DIM
GATE_COLS = 3 * N_HEADS
NSA_IN_COLS = Q_COLS + 6 * KV_COLS + GATE_COLS
ALIBI_MAX = 8.0
NEG_INF = -1e30
FORCE_BONUS = 1e4

kernel_name = 'hybrid_rglru_nsa_trunk'


def _rmsnorm(x, g):
    xf = x.astype(jnp.float32)
    y = xf * lax.rsqrt(jnp.mean(xf * xf, axis=-1, keepdims=True) + RMS_EPS)
    return (y * g.astype(jnp.float32)).astype(x.dtype)


def _masked_softmax(s, mask):
    s = jnp.where(mask, s, NEG_INF)
    m = jnp.max(s, axis=-1, keepdims=True)
    p = jnp.where(mask, jnp.exp(s - m), 0.0)
    return p / jnp.maximum(jnp.sum(p, axis=-1, keepdims=True), 1e-30)


def _alibi_slopes():
    h = jnp.arange(1, N_HEADS + 1, dtype=jnp.float32)
    return jnp.exp2(-ALIBI_MAX * h / N_HEADS).reshape(N_KV_GROUPS, HEADS_PER_GROUP)


def _sq_relu_mlp(h, w_up, w_down):
    u = jax.nn.relu(h @ w_up)
    return (u * u) @ w_down


def _causal_depthwise_conv(x, w, b):
    y = lax.conv_general_dilated(
        x, w[:, None, :].astype(x.dtype), window_strides=(1,),
        padding=[(CONV_W - 1, 0)], dimension_numbers=('NWC', 'WIO', 'NWC'),
        feature_group_count=x.shape[-1])
    return y + b


def _lru_combine(left, right):
    a_l, b_l = left
    a_r, b_r = right
    return a_l * a_r, a_r * b_l + b_r


def _rglru_mixer(h, w_in, conv_w, conv_b, w_a, b_a, w_x, b_x, lam, w_out):
    B, S, _ = h.shape
    proj = h @ w_in
    y = jax.nn.gelu(proj[..., :D_RNN], approximate=True)
    xb = _causal_depthwise_conv(proj[..., D_RNN:], conv_w, conv_b)
    xr = xb.reshape(B, S, RG_BLOCKS, RG_BLOCK_W)
    r = jax.nn.sigmoid(jnp.einsum('bsnc,ncd->bsnd', xr, w_a).reshape(B, S, D_RNN) + b_a)
    i = jax.nn.sigmoid(jnp.einsum('bsnc,ncd->bsnd', xr, w_x).reshape(B, S, D_RNN) + b_x)
    log_a = -RG_C * r.astype(jnp.float32) * jax.nn.softplus(-lam.astype(jnp.float32))
    a = jnp.exp(log_a)
    u = jnp.sqrt(-jnp.expm1(2.0 * log_a)) * (i * xb).astype(jnp.float32)
    _, hs = lax.associative_scan(_lru_combine, (a, u), axis=1)
    return (hs.astype(h.dtype) * y) @ w_out


def _compress(z, pe, w1, w2):
    B, S, G, DH = z.shape
    n_chunk = S // CMP_STRIDE
    nc = n_chunk - CMP_RATIO + 1
    chunks = z.reshape(B, n_chunk, CMP_STRIDE, G, DH)
    blocks = jnp.concatenate([chunks[:, r:r + nc] for r in range(CMP_RATIO)], axis=2)
    blocks = blocks + pe[None, None, :, None, :]
    flat = jnp.transpose(blocks, (0, 1, 3, 2, 4)).reshape(B, nc, G, CMP_LEN * DH)
    return jax.nn.gelu(flat @ w1, approximate=True) @ w2


def _cmp_to_slc_map(nc, nb):
    cs = jnp.arange(nc) * CMP_STRIDE
    ss = jnp.arange(nb) * SLC_LEN
    ov = jnp.minimum(cs[:, None] + CMP_LEN, ss[None, :] + SLC_LEN) - jnp.maximum(cs[:, None], ss[None, :])
    return (jnp.maximum(ov, 0) / CMP_STRIDE).astype(jnp.float32)


def _nsa_attend(q, gates, k_c, v_c, k_s, v_s, k_w, v_w):
    B, S = q.shape[0], q.shape[1]
    nqb = S // Q_BLOCK
    nc = k_c.shape[1]
    nb = k_s.shape[2]
    n_sel = min(N_SELECT, nb)
    G, Hg, DH = N_KV_GROUPS, HEADS_PER_GROUP, HEAD_DIM
    qx = q.reshape(B * nqb, Q_BLOCK, G, Hg, DH)
    gx = gates.reshape(B * nqb, Q_BLOCK, G, Hg, 3)
    slopes = _alibi_slopes()[:, :, None, None]
    cmp_map = _cmp_to_slc_map(nc, nb)
    cmp_end = jnp.arange(nc) * CMP_STRIDE + (CMP_LEN - 1)
    blk_ids = jnp.arange(nb)
    key_off = jnp.arange(SLC_LEN)
    win_off = jnp.arange(WINDOW + Q_BLOCK)
    gi = jnp.arange(G)[:, None, None]
    scale = HEAD_DIM ** -0.5
    zero = jnp.zeros((), jnp.int32)

    def step(args):
        idx, q_blk, g_blk = args
        b = idx // nqb
        qb = idx % nqb
        t = qb * Q_BLOCK + jnp.arange(Q_BLOCK)
        qf = q_blk.astype(jnp.float32) * scale

        kc = lax.dynamic_index_in_dim(k_c, b, 0, keepdims=False).astype(jnp.float32)
        vc = lax.dynamic_index_in_dim(v_c, b, 0, keepdims=False).astype(jnp.float32)
        d_c = t[:, None] - cmp_end[None, :]
        s_c = jnp.einsum('qghd,ngd->ghqn', qf, kc) - slopes * d_c.astype(jnp.float32)
        p_c = _masked_softmax(s_c, d_c >= 0)
        o_c = jnp.einsum('ghqn,ngd->qghd', p_c, vc)

        imp = jnp.einsum('ghqn,nj->gqj', p_c, cmp_map)
        cur = t // SLC_LEN
        forced = (blk_ids[None, :] == 0) | (blk_ids[None, :] == cur[:, None]) | (blk_ids[None, :] == cur[:, None] - 1)
        score = jnp.where(blk_ids[None, :] <= cur[:, None], imp + FORCE_BONUS * forced, -1.0)
        sel = lax.top_k(score, n_sel)[1]
        sel_ok = sel <= cur[None, :, None]

        ks = lax.dynamic_index_in_dim(k_s, b, 0, keepdims=False)
        vs = lax.dynamic_index_in_dim(v_s, b, 0, keepdims=False)
        k_sel = ks[gi, sel].astype(jnp.float32).reshape(G, Q_BLOCK, n_sel * SLC_LEN, DH)
        v_sel = vs[gi, sel].astype(jnp.float32).reshape(G, Q_BLOCK, n_sel * SLC_LEN, DH)
        pos = (sel[..., None] * SLC_LEN + key_off).reshape(G, Q_BLOCK, n_sel * SLC_LEN)
        d_s = t[None, :, None] - pos
        m_s = (d_s >= 0) & jnp.repeat(sel_ok, SLC_LEN, axis=-1)
        s_s = jnp.einsum('qghd,gqkd->ghqk', qf, k_sel) - slopes * d_s[:, None].astype(jnp.float32)
        p_s = _masked_softmax(s_s, m_s[:, None])
        o_s = jnp.einsum('ghqk,gqkd->qghd', p_s, v_sel)

        kw = lax.dynamic_slice(k_w, (b, qb * Q_BLOCK, zero, zero), (1, WINDOW + Q_BLOCK, G, DH))[0].astype(jnp.float32)
        vw = lax.dynamic_slice(v_w, (b, qb * Q_BLOCK, zero, zero), (1, WINDOW + Q_BLOCK, G, DH))[0].astype(jnp.float32)
        s_pos = qb * Q_BLOCK - WINDOW + win_off
        d_w = t[:, None] - s_pos[None, :]
        m_w = (d_w >= 0) & (d_w < WINDOW) & (s_pos[None, :] >= 0)
        s_w = jnp.einsum('qghd,kgd->ghqk', qf, kw) - slopes * d_w.astype(jnp.float32)
        p_w = _masked_softmax(s_w, m_w)
        o_w = jnp.einsum('ghqk,kgd->qghd', p_w, vw)

        g = g_blk.astype(jnp.float32)
        o = g[..., 0:1] * o_c + g[..., 1:2] * o_s + g[..., 2:3] * o_w
        return o.reshape(Q_BLOCK, N_HEADS * HEAD_DIM)

    out = lax.map(step, (jnp.arange(B * nqb, dtype=jnp.int32), qx, gx))
    return out.reshape(B, S, N_HEADS * HEAD_DIM)


def _nsa_mixer(h, w_in, b_gate, pe_k, pe_v, w1_k, w2_k, w1_v, w2_v, w_out):
    B, S, _ = h.shape
    proj = h @ w_in
    q = proj[..., :Q_COLS].reshape(B, S, N_KV_GROUPS, HEADS_PER_GROUP, HEAD_DIM)
    kv = proj[..., Q_COLS:Q_COLS + 6 * KV_COLS].reshape(B, S, 6, N_KV_GROUPS, HEAD_DIM)
    gates = jax.nn.sigmoid(proj[..., Q_COLS + 6 * KV_COLS:] + b_gate).reshape(B, S, N_HEADS, 3)
    k_c = _compress(kv[:, :, 0], pe_k, w1_k, w2_k)
    v_c = _compress(kv[:, :, 1], pe_v, w1_v, w2_v)
    nb = S // SLC_LEN
    k_s = jnp.transpose(kv[:, :, 2].reshape(B, nb, SLC_LEN, N_KV_GROUPS, HEAD_DIM), (0, 3, 1, 2, 4))
    v_s = jnp.transpose(kv[:, :, 3].reshape(B, nb, SLC_LEN, N_KV_GROUPS, HEAD_DIM), (0, 3, 1, 2, 4))
    pad = ((0, 0), (WINDOW, 0), (0, 0), (0, 0))
    k_w = jnp.pad(kv[:, :, 4], pad)
    v_w = jnp.pad(kv[:, :, 5], pad)
    o = _nsa_attend(q, gates, k_c, v_c, k_s, v_s, k_w, v_w)
    return o.astype(h.dtype) @ w_out


def setup_inputs(seed: int = 0) -> dict:
    key = jax.random.key(seed)
    ks = jax.random.split(key, 24)
    f32 = jnp.float32
    nrm = lambda k, shape, s: jax.random.normal(k, shape, f32) * s
    u = jax.random.uniform(ks[11], (N_RG_LAYERS, D_RNN), f32, minval=0.9, maxval=0.999)
    sig = u ** (1.0 / RG_C)
    return {
        'x': nrm(ks[0], (BATCH, SEQ, D_MODEL), 1.0),
        'norm_mix': 1.0 + nrm(ks[1], (DEPTH, D_MODEL), 0.02),
        'norm_ffn': 1.0 + nrm(ks[2], (DEPTH, D_MODEL), 0.02),
        'norm_final': 1.0 + nrm(ks[3], (D_MODEL,), 0.02),
        'rg_w_in': nrm(ks[4], (N_RG_LAYERS, D_MODEL, 2 * D_RNN), D_MODEL ** -0.5),
        'rg_conv_w': nrm(ks[5], (N_RG_LAYERS, CONV_W, D_RNN), CONV_W ** -0.5),
        'rg_conv_b': nrm(ks[6], (N_RG_LAYERS, D_RNN), 0.01),
        'rg_w_a': nrm(ks[7], (N_RG_LAYERS, RG_BLOCKS, RG_BLOCK_W, RG_BLOCK_W), RG_BLOCK_W ** -0.5),
        'rg_b_a': nrm(ks[8], (N_RG_LAYERS, D_RNN), 0.01),
        'rg_w_x': nrm(ks[9], (N_RG_LAYERS, RG_BLOCKS, RG_BLOCK_W, RG_BLOCK_W), RG_BLOCK_W ** -0.5),
        'rg_b_x': nrm(ks[10], (N_RG_LAYERS, D_RNN), 0.01),
        'rg_lambda': jnp.log(sig) - jnp.log1p(-sig),
        'rg_w_out': nrm(ks[12], (N_RG_LAYERS, D_RNN, D_MODEL), D_RNN ** -0.5),
        'nsa_w_in': nrm(ks[13], (N_NSA_LAYERS, D_MODEL, NSA_IN_COLS), D_MODEL ** -0.5),
        'nsa_b_gate': nrm(ks[14], (N_NSA_LAYERS, GATE_COLS), 0.01),
        'nsa_pe_k': nrm(ks[15], (N_NSA_LAYERS, CMP_LEN, HEAD_DIM), 0.02),
        'nsa_pe_v': nrm(ks[16], (N_NSA_LAYERS, CMP_LEN, HEAD_DIM), 0.02),
        'nsa_w1_k': nrm(ks[17], (N_NSA_LAYERS, CMP_LEN * HEAD_DIM, HEAD_DIM), (CMP_LEN * HEAD_DIM) ** -0.5),
        'nsa_w2_k': nrm(ks[18], (N_NSA_LAYERS, HEAD_DIM, HEAD_DIM), HEAD_DIM ** -0.5),
        'nsa_w1_v': nrm(ks[19], (N_NSA_LAYERS, CMP_LEN * HEAD_DIM, HEAD_DIM), (CMP_LEN * HEAD_DIM) ** -0.5),
        'nsa_w2_v': nrm(ks[20], (N_NSA_LAYERS, HEAD_DIM, HEAD_DIM), HEAD_DIM ** -0.5),
        'nsa_w_out': nrm(ks[21], (N_NSA_LAYERS, N_HEADS * HEAD_DIM, D_MODEL), (N_HEADS * HEAD_DIM) ** -0.5),
        'mlp_w_up': nrm(ks[22], (DEPTH, D_MODEL, D_FF), D_MODEL ** -0.5),
        'mlp_w_down': nrm(ks[23], (DEPTH, D_FF, D_MODEL), D_FF ** -0.5),
    }


def reference(x, norm_mix, norm_ffn, norm_final,
              rg_w_in, rg_conv_w, rg_conv_b, rg_w_a, rg_b_a, rg_w_x, rg_b_x, rg_lambda, rg_w_out,
              nsa_w_in, nsa_b_gate, nsa_pe_k, nsa_pe_v, nsa_w1_k, nsa_w2_k, nsa_w1_v, nsa_w2_v, nsa_w_out,
              mlp_w_up, mlp_w_down):
    for i in range(DEPTH):
        h = _rmsnorm(x, norm_mix[i])
        j = i // N_MIXERS
        if i % N_MIXERS == 0:
            x = x + _rglru_mixer(h, rg_w_in[j], rg_conv_w[j], rg_conv_b[j], rg_w_a[j], rg_b_a[j],
                                 rg_w_x[j], rg_b_x[j], rg_lambda[j], rg_w_out[j])
        else:
            x = x + _nsa_mixer(h, nsa_w_in[j], nsa_b_gate[j], nsa_pe_k[j], nsa_pe_v[j],
                               nsa_w1_k[j], nsa_w2_k[j], nsa_w1_v[j], nsa_w2_v[j], nsa_w_out[j])
        h = _rmsnorm(x, norm_ffn[i])
        x = x + _sq_relu_mlp(h, mlp_w_up[i], mlp_w_down[i])
    return _rmsnorm(x, norm_final)
```

```cpp
#include <hip/hip_runtime.h>
#include <hip/hip_cooperative_groups.h>
#include <cstdio>
#include <cstdint>
namespace cg = cooperative_groups;

#define LAS __attribute__((address_space(3)))
typedef unsigned short bf16_t;
typedef short bf16x8 __attribute__((ext_vector_type(8)));
typedef float f32x4 __attribute__((ext_vector_type(4)));
typedef float f32x2 __attribute__((ext_vector_type(2)));
typedef float f32x16 __attribute__((ext_vector_type(16)));
typedef unsigned u32x4 __attribute__((ext_vector_type(4)));
typedef unsigned u32x2 __attribute__((ext_vector_type(2)));
typedef __bf16 bf16x2_t __attribute__((ext_vector_type(2)));

#ifndef MK_MULTI
#define MK_MULTI 0
#endif

constexpr int T_TOK = 32768, DM = 1024, SEQ = 8192, DFF = 4096;
constexpr int NSA_N = 2608, NSA_NPAD = 2816;
constexpr size_t MiB = 1u << 20;
constexpr size_t WS_KMAX = 4096 + 128;
constexpr size_t WS_BAR = 4096;
constexpr size_t WS_C1 = 0;
constexpr size_t W_RGIN = 2 * MiB;
constexpr size_t W_RGGATE = W_RGIN + 8 * MiB;
constexpr size_t W_RGOUT = W_RGGATE + 2 * MiB;
constexpr size_t NSAIN_BYTES = (size_t)NSA_NPAD * 1024 * 2;
constexpr size_t W_NSAIN = W_RGOUT + 4 * MiB;
constexpr size_t W_W1 = W_NSAIN + 2 * NSAIN_BYTES;
constexpr size_t W_NSAOUT = W_W1 + 4 * MiB;
constexpr size_t W_UP = W_NSAOUT + 4 * MiB;
constexpr size_t W_DN = W_UP + 32 * MiB;
constexpr size_t W_END = W_DN + 32 * MiB;
static_assert(W_END <= 100 * MiB, "weights");
constexpr size_t WS_HB = 100 * MiB;
constexpr size_t WS_XPRE = 164 * MiB;
constexpr size_t WS_BIG = 228 * MiB;
constexpr size_t WS_A = WS_BIG, WS_XB = WS_BIG + 64 * MiB, WS_U = WS_BIG + 128 * MiB, WS_Y = WS_BIG + 192 * MiB;
constexpr size_t WS_Q = WS_BIG, WS_KV = WS_BIG + 64 * MiB, WS_GATE = WS_BIG + 160 * MiB, WS_MID = WS_BIG + 168 * MiB, WS_KC = WS_BIG + 170 * MiB, WS_VC = WS_BIG + 171 * MiB;
constexpr size_t WS_SUMP = 484 * MiB, WS_SUMH = 486 * MiB, WS_CARRY = 488 * MiB, WS_PART = 490 * MiB, WS_END = 492 * MiB;
constexpr size_t KV_ELEMS = (size_t)T_TOK * 256;

constexpr int LDS_BYTES = 147456;
constexpr int NTHREADS = 512;

__device__ __forceinline__ unsigned pk_bf16(float lo, float hi) { f32x2 v = {lo, hi}; bf16x2_t b = __builtin_convertvector(v, bf16x2_t); return __builtin_bit_cast(unsigned, b); }
__device__ __forceinline__ float bf_lo(unsigned w) { return __builtin_bit_cast(float, w << 16); }
__device__ __forceinline__ float bf_hi(unsigned w) { return __builtin_bit_cast(float, w & 0xffff0000u); }
__device__ __forceinline__ float bf2f(bf16_t h) { return __builtin_bit_cast(float, (unsigned)h << 16); }
__device__ __forceinline__ float fast_exp2(float x) { return __builtin_amdgcn_exp2f(x); }
__device__ __forceinline__ float fast_rcp(float x) { return __builtin_amdgcn_rcpf(x); }
__device__ __forceinline__ float sigmoidf_(float z) { return fast_rcp(1.f + fast_exp2(-1.4426950408889634f * z)); }
__device__ __forceinline__ float gelu_tanh(float x) {
    const float z = x + 0.044715f * x * x * x;
    return x * fast_rcp(1.f + fast_exp2(-2.3022081983f * z));
}
__device__ __forceinline__ float my_log1p(float x) {
    return (x < 0.03f) ? x * (1.f - x * (0.5f - x * (0.33333334f - 0.25f * x))) : __builtin_amdgcn_logf(1.f + x) * 0.6931471806f;
}
__device__ __forceinline__ float my_expm1(float x) {
    const float p = x * (1.f + x * (0.5f + x * (0.16666667f + x * (0.041666668f + x * (0.0083333338f + x * 0.0013888889f)))));
    return (x > -0.25f) ? p : fast_exp2(1.4426950408889634f * x) - 1.f;
}
__device__ __forceinline__ int vslot(int k) { return (k & 19) | ((k & 4) << 1) | ((k & 8) >> 1); }
__device__ __forceinline__ float shx(float v, int o, int lane) { return __builtin_bit_cast(float, __builtin_amdgcn_ds_bpermute((lane ^ o) << 2, __builtin_bit_cast(int, v))); }
__device__ __forceinline__ float wave_sum(float v, int lane) {
#pragma unroll
    for (int o = 1; o < 64; o <<= 1) v += shx(v, o, lane);
    return v;
}

namespace pg8 {
constexpr int BM = 256, BK = 64, HALF = 128, HTB = HALF * BK * 2, NXCD = 8, WGM = 4;
__host__ __device__ __forceinline__ int lds_byte(int r, int c) { const int st = (r >> 4) * 2 + (c >> 5), rr = r & 15, cc = c & 31, ob = rr * 64 + cc * 2; return st * 1024 + (ob ^ (((ob >> 9) & 1) << 5)); }
__host__ __device__ __forceinline__ void stage_rc(int b, int& R, int& C) { const int st = b / 1024, sb = b % 1024, swz = sb ^ (((sb >> 9) & 1) << 5); R = (st >> 1) * 16 + swz / 64; C = (st & 1) * 32 + (swz % 64) / 2; }
__host__ __device__ __forceinline__ int perm32(int rho) { const int n = rho >> 4, i = rho & 15; return 8 * (i >> 2) + 4 * n + (i & 3); }

struct Unit { int pm, pn; };
struct Gemm { const bf16_t* A; const bf16_t* Bt; int lda, ldb, K, adiv, amul; };

struct StaticOrder {
    int nM, nN, nwg, G, c, alt;
    __device__ void init(int M, int N, int G_, int c_, int alt_ = 0) { nM = M / BM; nN = N / BM; nwg = nM * nN; G = G_; c = c_; alt = alt_; }
    __device__ bool next(int i, Unit& u) const {
        const long L = (long)i * G + c; if (L >= nwg) return false;
        int wgid = (int)L; { const int q = nwg / NXCD, r = nwg % NXCD, xcd = wgid % NXCD, off = wgid / NXCD; wgid = (xcd < r ? xcd * (q + 1) : r * (q + 1) + (xcd - r) * q) + off; }
        if (alt) {
            const int band = wgid >> 8, w = wgid & 255, rnd = w >> 5, inner = w & 31;
            u.pm = band * 16 + (rnd & 3) * 4 + (inner & 3); u.pn = (rnd >> 2) * 8 + (inner >> 2); return true; }
        const int nig = WGM * nN, gid = wgid / nig, fm = gid * WGM, gsz = (nM - fm) < WGM ? (nM - fm) : WGM;
        u.pm = fm + ((wgid % nig) % gsz); u.pn = (wgid % nig) / gsz; return true;
    }
};

template <class Epi>
__device__ __forceinline__ void gemm_phase(LAS unsigned char* lds, const int tid, const Gemm g, const StaticOrder& S, const Epi& E) {
    const int wid = __builtin_amdgcn_readfirstlane(tid >> 6), lane = tid & 63, wr = wid >> 2, wc = wid & 3, fr = lane & 15, fq = lane >> 4;
    const int K = g.K, nt = K / BK;
    unsigned voffA, voffB;
    { int R, C; stage_rc(tid * 16, R, C); const int Rb = (R & ~31) + perm32(R & 31);
      voffA = (unsigned)(R * g.lda + C) * 2u; voffB = (unsigned)(Rb * g.ldb + C) * 2u; }
    const size_t rstep_voffA = (size_t)64 * g.lda * 2, rstep_voffB = (size_t)64 * g.ldb * 2;
    const size_t kstep = (size_t)(BK * 2);
    const size_t hstepA = (size_t)HALF * g.lda * 2, hstepB = (size_t)HALF * g.ldb * 2;
    const unsigned ldsw = (unsigned)wid * 1024u;
    const int aoff = lds_byte(wr * 64 + fr, fq * 8), boff = lds_byte(wc * 32 + fr, fq * 8);
#define PG8_TA(u) ((const char*)g.A + ((size_t)(u).pm * 256 * g.lda + (size_t)((u).pn / g.adiv) * g.amul) * 2)
#define PG8_TB(u) ((const char*)g.Bt + (size_t)(u).pn * 256 * g.ldb * 2)
#define PG8_SA(b, h) (((b) * 2 + (h)) * HTB)
#define PG8_SB(b, h) ((4 + (b) * 2 + (h)) * HTB)
#define PG8_STAGE(bufoff, gbase, voff) do { _Pragma("unroll") for (int _i = 0; _i < 2; ++_i) \
        __builtin_amdgcn_global_load_lds((const unsigned*)((const char*)(gbase) + _i * rstep_##voff + (voff)), (LAS unsigned*)(lds + (bufoff) + ldsw + _i * 8192), 16, 0, 0); } while (0)
#define PG8_LDA(dst, b, h) do { _Pragma("unroll") for (int m = 0; m < 4; ++m) _Pragma("unroll") for (int k = 0; k < 2; ++k) dst[m][k] = *(const LAS bf16x8*)(lds + PG8_SA(b, h) + aoff + m * 2048 + k * 1024); } while (0)
#define PG8_LDB(dst, b, h) do { _Pragma("unroll") for (int n = 0; n < 2; ++n) _Pragma("unroll") for (int k = 0; k < 2; ++k) dst[n][k] = *(const LAS bf16x8*)(lds + PG8_SB(b, h) + boff + n * 2048 + k * 1024); } while (0)
#define PG8_MMA(ai, bj, At, Bt) do { __builtin_amdgcn_s_setprio(1); _Pragma("unroll") for (int m = 0; m < 4; ++m) _Pragma("unroll") for (int n = 0; n < 2; ++n) _Pragma("unroll") for (int k = 0; k < 2; ++k) \
        acc[ai][bj][m][n] = __builtin_amdgcn_mfma_f32_16x16x32_bf16(Bt[n][k], At[m][k], acc[ai][bj][m][n], 0, 0, 0); __builtin_amdgcn_s_setprio(0); } while (0)
#define PG8_WAIT_V(n) asm volatile("s_waitcnt vmcnt(" #n ")" ::: "memory")
#define PG8_WAIT_L(n) asm volatile("s_waitcnt lgkmcnt(" #n ")" ::: "memory")
#define PG8_BAR __builtin_amdgcn_s_barrier()
#define PG8_SCHED __builtin_amdgcn_sched_barrier(0)
    Unit cur, nxt; int ui = 0;
    if (!S.next(0, cur)) return;
    f32x4 acc[2][2][4][2];
#pragma unroll
    for (int a = 0; a < 2; ++a)
#pragma unroll
        for (int b = 0; b < 2; ++b)
#pragma unroll
            for (int m = 0; m < 4; ++m)
#pragma unroll
                for (int n = 0; n < 2; ++n) acc[a][b][m][n] = (f32x4){0.f, 0.f, 0.f, 0.f};
    bf16x8 At[4][2], B0[2][2], B1[2][2];
    const char* cA = PG8_TA(cur); const char* cB = PG8_TB(cur);
    PG8_STAGE(PG8_SB(0, 0), cB, voffB); PG8_STAGE(PG8_SB(0, 1), cB + hstepB, voffB); PG8_STAGE(PG8_SA(0, 0), cA, voffA); PG8_STAGE(PG8_SA(0, 1), cA + hstepA, voffA);
    if (wr == 1) PG8_BAR;
    PG8_WAIT_V(2); PG8_BAR;
    PG8_STAGE(PG8_SB(1, 0), cB + kstep, voffB); PG8_STAGE(PG8_SA(1, 0), cA + kstep, voffA); PG8_STAGE(PG8_SB(1, 1), cB + hstepB + kstep, voffB);
    PG8_WAIT_V(6); PG8_BAR;
    for (;;) {
        const bool has_next = S.next(ui + 1, nxt);
        const char* nA = has_next ? PG8_TA(nxt) : cA; const char* nB = has_next ? PG8_TB(nxt) : cB;
        for (int t = 0; t < nt; t += 2) {
            const bool last = (t == nt - 2);
            const char* a1 = cA + (size_t)(t + 1) * kstep;
            const char* a2 = last ? nA : cA + (size_t)(t + 2) * kstep; const char* b2 = last ? nB : cB + (size_t)(t + 2) * kstep;
            const char* a3 = a2 + kstep; const char* b3 = b2 + kstep;
            PG8_LDB(B0, 0, 0); PG8_LDB(B1, 0, 1); PG8_SCHED; PG8_LDA(At, 0, 0); PG8_STAGE(PG8_SA(1, 1), a1 + hstepA, voffA);
            PG8_WAIT_V(8); PG8_WAIT_L(0); PG8_BAR; PG8_MMA(0, 0, At, B0); PG8_MMA(0, 1, At, B1); PG8_BAR; PG8_SCHED;
            PG8_LDA(At, 0, 1); PG8_STAGE(PG8_SB(0, 0), b2, voffB); PG8_STAGE(PG8_SB(0, 1), b2 + hstepB, voffB); PG8_STAGE(PG8_SA(0, 0), a2, voffA);
            PG8_WAIT_V(8); PG8_WAIT_L(0); PG8_BAR; PG8_MMA(1, 0, At, B0); PG8_MMA(1, 1, At, B1); PG8_BAR; PG8_SCHED;
            PG8_LDB(B0, 1, 0); PG8_LDB(B1, 1, 1); PG8_SCHED; PG8_LDA(At, 1, 0); PG8_STAGE(PG8_SA(0, 1), a2 + hstepA, voffA);
            PG8_WAIT_V(8); PG8_WAIT_L(0); PG8_BAR; PG8_MMA(0, 0, At, B0); PG8_MMA(0, 1, At, B1); PG8_BAR; PG8_SCHED;
            PG8_LDA(At, 1, 1); PG8_STAGE(PG8_SB(1, 0), b3, voffB); PG8_STAGE(PG8_SB(1, 1), b3 + hstepB, voffB); PG8_STAGE(PG8_SA(1, 0), a3, voffA);
            PG8_WAIT_V(8); PG8_WAIT_L(0); PG8_BAR; PG8_MMA(1, 0, At, B0); PG8_MMA(1, 1, At, B1); PG8_BAR; PG8_SCHED;
        }
        if (wr == 0) PG8_BAR;
        E(acc, cur, wr, wc, fr, fq);
        if (!has_next) break;
#pragma unroll
        for (int a = 0; a < 2; ++a)
#pragma unroll
            for (int b = 0; b < 2; ++b)
#pragma unroll
                for (int m = 0; m < 4; ++m)
#pragma unroll
                    for (int n = 0; n < 2; ++n) acc[a][b][m][n] = (f32x4){0.f, 0.f, 0.f, 0.f};
        cur = nxt; cA = nA; cB = nB; ++ui;
        if (wr == 1) PG8_BAR;
    }
    PG8_WAIT_V(0);
    PG8_BAR;
#undef PG8_TA
#undef PG8_TB
#undef PG8_SA
#undef PG8_SB
#undef PG8_STAGE
#undef PG8_LDA
#undef PG8_LDB
#undef PG8_MMA
#undef PG8_WAIT_V
#undef PG8_WAIT_L
#undef PG8_BAR
#undef PG8_SCHED
}

typedef const f32x4 (&AccRef)[2][2][4][2];
template <int N> __device__ __forceinline__ float dpp_shr(float v, float ident) {
    return __builtin_bit_cast(float, __builtin_amdgcn_update_dpp(__builtin_bit_cast(int, ident), __builtin_bit_cast(int, v), 0x110 + N, 0xf, 0xf, false));
}
__device__ __forceinline__ void lru_row_scan(float& P, float& H) {
    { const float Pl = dpp_shr<1>(P, 1.f), Hl = dpp_shr<1>(H, 0.f); H = __builtin_fmaf(P, Hl, H); P *= Pl; }
    { const float Pl = dpp_shr<2>(P, 1.f), Hl = dpp_shr<2>(H, 0.f); H = __builtin_fmaf(P, Hl, H); P *= Pl; }
    { const float Pl = dpp_shr<4>(P, 1.f), Hl = dpp_shr<4>(H, 0.f); H = __builtin_fmaf(P, Hl, H); P *= Pl; }
    { const float Pl = dpp_shr<8>(P, 1.f), Hl = dpp_shr<8>(H, 0.f); H = __builtin_fmaf(P, Hl, H); P *= Pl; }
}
__device__ __forceinline__ float row_rs(const float* PART, int row) {
    const f32x4* p = (const f32x4*)(PART + (size_t)row * 16); const f32x4 a = p[0], b = p[1], c = p[2], d = p[3];
    const float s = (((a.x + a.y) + (a.z + a.w)) + ((b.x + b.y) + (b.z + b.w))) + (((c.x + c.y) + (c.z + c.w)) + ((d.x + d.y) + (d.z + d.w)));
    return __builtin_amdgcn_rsqf(s * (1.f / 1024.f) + 1e-6f);
}

struct EpiRgIn { unsigned char* ws;
    __device__ __forceinline__ void operator()(AccRef acc, const Unit& u, int wr, int wc, int fr, int fq) const {
        const float* const PART = (const float*)(ws + WS_PART);
        const bool isY = u.pn < 4; bf16_t* base = isY ? (bf16_t*)(ws + WS_Y) : (bf16_t*)(ws + WS_XPRE); const int colt = (u.pn & 3) * 256 + wc * 32 + 8 * fq;
#pragma unroll
        for (int ai = 0; ai < 2; ++ai)
#pragma unroll
            for (int m = 0; m < 4; ++m) { const int row = u.pm * 256 + ai * 128 + wr * 64 + m * 16 + fr; const float rs = row_rs(PART, row);
#pragma unroll
                for (int bj = 0; bj < 2; ++bj) { f32x4 v0 = acc[ai][bj][m][0] * rs, v1 = acc[ai][bj][m][1] * rs;
                    if (isY) {
#pragma unroll
                        for (int e = 0; e < 4; ++e) { v0[e] = gelu_tanh(v0[e]); v1[e] = gelu_tanh(v1[e]); } }
                    u32x4 w; w.x = pk_bf16(v0[0], v0[1]); w.y = pk_bf16(v0[2], v0[3]); w.z = pk_bf16(v1[0], v1[1]); w.w = pk_bf16(v1[2], v1[3]);
                    *(u32x4*)(base + (size_t)row * 1024 + colt + bj * 128) = w; } }
    }
};
struct EpiGates { unsigned char* ws; const float* b_a; const float* b_x; const float* lam;
    __device__ __forceinline__ void operator()(AccRef acc, const Unit& u, int wr, int wc, int fr_, int fq_) const {
        const int le = __builtin_amdgcn_mbcnt_hi(~0u, __builtin_amdgcn_mbcnt_lo(~0u, 0u)), fr = le & 15, fq = le >> 4; (void)fr_; (void)fq_;
        const bf16_t* const XB = (const bf16_t*)(ws + WS_XB); bf16_t* const Aout = (bf16_t*)(ws + WS_A); bf16_t* const Uout = (bf16_t*)(ws + WS_U);
        const int ch0 = u.pn * 128 + wc * 32 + 8 * fq;
        float sp[8], ba[8], bx[8];
#pragma unroll
        for (int e = 0; e < 8; ++e) { sp[e] = 8.f * my_log1p(fast_exp2(-1.4426950408889634f * lam[ch0 + e])); ba[e] = b_a[ch0 + e]; bx[e] = b_x[ch0 + e]; }
#pragma unroll
        for (int ai = 0; ai < 2; ++ai) {
            float Pr[8], Hr[8];
#pragma unroll
            for (int e = 0; e < 8; ++e) { Pr[e] = 1.f; Hr[e] = 0.f; }
#pragma unroll
            for (int m = 0; m < 4; ++m) { const int row = u.pm * 256 + ai * 128 + wr * 64 + m * 16 + fr;
                const u32x4 xw = *(const u32x4*)(XB + (size_t)row * 1024 + ch0);
                float xb[8] = {bf_lo(xw.x), bf_hi(xw.x), bf_lo(xw.y), bf_hi(xw.y), bf_lo(xw.z), bf_hi(xw.z), bf_lo(xw.w), bf_hi(xw.w)};
                float av[8], uv[8];
#pragma unroll
                for (int e = 0; e < 8; ++e) { const float ra = acc[ai][0][m][e >> 2][e & 3] + ba[e], rx = acc[ai][1][m][e >> 2][e & 3] + bx[e];
                    const float r = sigmoidf_(ra), ig = sigmoidf_(rx);
                    const float la = -sp[e] * r; av[e] = -my_expm1(la);     uv[e] = __builtin_amdgcn_sqrtf(fmaxf(-my_expm1(2.f * la), 0.f)) * ig * xb[e]; }
                u32x4 wa; wa.x = pk_bf16(av[0], av[1]); wa.y = pk_bf16(av[2], av[3]); wa.z = pk_bf16(av[4], av[5]); wa.w = pk_bf16(av[6], av[7]);
                *(u32x4*)(Aout + (size_t)row * 1024 + ch0) = wa;
                u32x4 w; w.x = pk_bf16(uv[0], uv[1]); w.y = pk_bf16(uv[2], uv[3]); w.z = pk_bf16(uv[4], uv[5]); w.w = pk_bf16(uv[6], uv[7]);
                *(u32x4*)(Uout + (size_t)row * 1024 + ch0) = w;
                const unsigned waw[4] = {wa.x, wa.y, wa.z, wa.w}, wuw[4] = {w.x, w.y, w.z, w.w};
#pragma unroll
                for (int e = 0; e < 8; ++e) { float P = 1.f - ((e & 1) ? bf_hi(waw[e >> 1]) : bf_lo(waw[e >> 1])), H = (e & 1) ? bf_hi(wuw[e >> 1]) : bf_lo(wuw[e >> 1]);
                    lru_row_scan(P, H);
                    Hr[e] = __builtin_fmaf(Hr[e], P, H); Pr[e] *= P; } }
            if (fr == 15) { const size_t so = (size_t)(u.pm * 4 + ai * 2 + wr) * 1024 + ch0; float* sp_ = (float*)(ws + WS_SUMP) + so; float* sh_ = (float*)(ws + WS_SUMH) + so;
                *(f32x4*)sp_ = (f32x4){Pr[0], Pr[1], Pr[2], Pr[3]}; *(f32x4*)(sp_ + 4) = (f32x4){Pr[4], Pr[5], Pr[6], Pr[7]};
                *(f32x4*)sh_ = (f32x4){Hr[0], Hr[1], Hr[2], Hr[3]}; *(f32x4*)(sh_ + 4) = (f32x4){Hr[4], Hr[5], Hr[6], Hr[7]}; }
        }
    }
};
struct EpiResid { unsigned char* ws;
    __device__ __forceinline__ void operator()(AccRef acc, const Unit& u, int wr, int wc, int fr_, int fq_) const {
        bf16_t* const X16 = (bf16_t*)(ws + WS_HB); float* const PART = (float*)(ws + WS_PART);
        const int lane = __builtin_amdgcn_mbcnt_hi(~0u, __builtin_amdgcn_mbcnt_lo(~0u, 0u)), fr = lane & 15, fq = lane >> 4; (void)fr_; (void)fq_;
#pragma unroll
        for (int ai = 0; ai < 2; ++ai)
#pragma unroll
            for (int m = 0; m < 4; ++m) { const int row = u.pm * 256 + ai * 128 + wr * 64 + m * 16 + fr; float ss = 0.f;
#pragma unroll
                for (int bj = 0; bj < 2; ++bj) { bf16_t* xp = X16 + (size_t)row * 1024 + u.pn * 256 + bj * 128 + wc * 32 + 8 * fq;
                    const u32x4 xw = *(const u32x4*)xp; const f32x4 a0 = acc[ai][bj][m][0], a1 = acc[ai][bj][m][1];
                    u32x4 w; w.x = pk_bf16(bf_lo(xw.x) + a0[0], bf_hi(xw.x) + a0[1]); w.y = pk_bf16(bf_lo(xw.y) + a0[2], bf_hi(xw.y) + a0[3]);
                    w.z = pk_bf16(bf_lo(xw.z) + a1[0], bf_hi(xw.z) + a1[1]); w.w = pk_bf16(bf_lo(xw.w) + a1[2], bf_hi(xw.w) + a1[3]);
                    *(u32x4*)xp = w;
                    ss += (bf_lo(w.x) * bf_lo(w.x) + bf_hi(w.x) * bf_hi(w.x)) + (bf_lo(w.y) * bf_lo(w.y) + bf_hi(w.y) * bf_hi(w.y));
                    ss += (bf_lo(w.z) * bf_lo(w.z) + bf_hi(w.z) * bf_hi(w.z)) + (bf_lo(w.w) * bf_lo(w.w) + bf_hi(w.w) * bf_hi(w.w)); }
                ss += shx(ss, 16, lane); ss += shx(ss, 32, lane);
                if (fq == 0) PART[(size_t)row * 16 + u.pn * 4 + wc] = ss; }
    }
};
struct EpiRelu2 { unsigned char* ws;
    __device__ __forceinline__ void operator()(AccRef acc, const Unit& u, int wr, int wc, int fr, int fq) const {
        bf16_t* const H = (bf16_t*)(ws + WS_BIG); const float* const PART = (const float*)(ws + WS_PART);
#pragma unroll
        for (int ai = 0; ai < 2; ++ai)
#pragma unroll
            for (int m = 0; m < 4; ++m) { const int row = u.pm * 256 + ai * 128 + wr * 64 + m * 16 + fr; const float rs = row_rs(PART, row);
#pragma unroll
                for (int bj = 0; bj < 2; ++bj) { f32x4 v0 = acc[ai][bj][m][0] * rs, v1 = acc[ai][bj][m][1] * rs;
#pragma unroll
                    for (int e = 0; e < 4; ++e) { const float a = fmaxf(v0[e], 0.f), b = fmaxf(v1[e], 0.f); v0[e] = a * a; v1[e] = b * b; }
                    u32x4 w; w.x = pk_bf16(v0[0], v0[1]); w.y = pk_bf16(v0[2], v0[3]); w.z = pk_bf16(v1[0], v1[1]); w.w = pk_bf16(v1[2], v1[3]);
                    __builtin_nontemporal_store(w, (u32x4*)(H + (size_t)row * 4096 + u.pn * 256 + bj * 128 + wc * 32 + 8 * fq)); } }
    }
};
struct EpiNsaIn { unsigned char* ws; const float* b_gate;
    __device__ __forceinline__ void operator()(AccRef acc, const Unit& u, int wr, int wc, int fr, int fq) const {
        bf16_t* const Q = (bf16_t*)(ws + WS_Q); bf16_t* const KV = (bf16_t*)(ws + WS_KV); float* const GATES = (float*)(ws + WS_GATE); const float* const PART = (const float*)(ws + WS_PART);
        constexpr float qscale = 0.125f * 1.4426950408889634f;
        const int pn = u.pn;
#pragma unroll
        for (int ai = 0; ai < 2; ++ai)
#pragma unroll
            for (int m = 0; m < 4; ++m) { const int row = u.pm * 256 + ai * 128 + wr * 64 + m * 16 + fr; const float rs = row_rs(PART, row);
#pragma unroll
                for (int bj = 0; bj < 2; ++bj) { const int colt = bj * 128 + wc * 32 + 8 * fq; f32x4 v0 = acc[ai][bj][m][0] * rs, v1 = acc[ai][bj][m][1] * rs;
                    if (pn < 4) { v0 = v0 * qscale; v1 = v1 * qscale;
                        u32x4 w; w.x = pk_bf16(v0[0], v0[1]); w.y = pk_bf16(v0[2], v0[3]); w.z = pk_bf16(v1[0], v1[1]); w.w = pk_bf16(v1[2], v1[3]);
                        *(u32x4*)(Q + (size_t)row * 1024 + pn * 256 + colt) = w;
                    } else if (pn < 10) { const int kvi = pn - 4, g = colt >> 6, d0 = colt & 63, b = row >> 13, s = row & 8191, bg = b * 4 + g;
                        bf16_t* base = KV + (size_t)kvi * KV_ELEMS;
                        u32x4 w; w.x = pk_bf16(v0[0], v0[1]); w.y = pk_bf16(v0[2], v0[3]); w.z = pk_bf16(v1[0], v1[1]); w.w = pk_bf16(v1[2], v1[3]);
                        if (kvi == 3 || kvi == 5) {
                            bf16_t* p = base + ((size_t)(bg * 256 + (s >> 5)) * 2048 + d0 * 32 + vslot(s & 31));
                            p[0] = (bf16_t)(w.x & 0xffff); p[32] = (bf16_t)(w.x >> 16); p[64] = (bf16_t)(w.y & 0xffff); p[96] = (bf16_t)(w.y >> 16);
                            p[128] = (bf16_t)(w.z & 0xffff); p[160] = (bf16_t)(w.z >> 16); p[192] = (bf16_t)(w.w & 0xffff); p[224] = (bf16_t)(w.w >> 16);
                        } else *(u32x4*)(base + ((size_t)(bg * 8192 + s) * 64 + d0)) = w;
                    } else if (colt < 48) { float* gp = GATES + (size_t)row * 48 + colt;
                        *(f32x4*)gp = (f32x4){sigmoidf_(v0[0] + b_gate[colt]), sigmoidf_(v0[1] + b_gate[colt + 1]), sigmoidf_(v0[2] + b_gate[colt + 2]), sigmoidf_(v0[3] + b_gate[colt + 3])};
                        *(f32x4*)(gp + 4) = (f32x4){sigmoidf_(v1[0] + b_gate[colt + 4]), sigmoidf_(v1[1] + b_gate[colt + 5]), sigmoidf_(v1[2] + b_gate[colt + 6]), sigmoidf_(v1[3] + b_gate[colt + 7])};
                    } } }
    }
};
struct EpiCmp { bf16_t* MID; const float* c1;
    __device__ __forceinline__ void operator()(AccRef acc, const Unit& u, int wr, int wc, int fr, int fq) const {
        const int colt = wc * 32 + 8 * fq;
        if (colt >= 64) return;
#pragma unroll
        for (int ai = 0; ai < 2; ++ai)
#pragma unroll
            for (int m = 0; m < 4; ++m) { const int row = u.pm * 256 + ai * 128 + wr * 64 + m * 16 + fr;
                f32x4 v0 = acc[ai][0][m][0], v1 = acc[ai][0][m][1];
#pragma unroll
                for (int e = 0; e < 4; ++e) { v0[e] = gelu_tanh(v0[e] + c1[colt + e]); v1[e] = gelu_tanh(v1[e] + c1[colt + 4 + e]); }
                u32x4 w; w.x = pk_bf16(v0[0], v0[1]); w.y = pk_bf16(v0[2], v0[3]); w.z = pk_bf16(v1[0], v1[1]); w.w = pk_bf16(v1[2], v1[3]);
                *(u32x4*)(MID + (size_t)row * 64 + colt) = w; }
    }
};
}

namespace att {
constexpr int KROW = 176, VROW = 80;
constexpr int KT_BYTES = 32 * KROW, VT_BYTES = 64 * VROW;
constexpr int OFF_K = 0, OFF_V = 4 * KT_BYTES, OFF_IMP = OFF_V + 4 * VT_BYTES, IMP_STRIDE = 132, OFF_SEL = OFF_IMP + 64 * IMP_STRIDE * 4, OFF_OT = OFF_SEL + 1024, ATT_LDS = OFF_OT + 32 * 512 * 4;
static_assert(ATT_LDS <= LDS_BYTES, "attention LDS");
enum { CMP1 = 0, CMP2 = 1, SEL = 2, WIN = 3 };
#define MFMA32(a, b, c) __builtin_amdgcn_mfma_f32_32x32x16_bf16((a), (b), (c), 0, 0, 0)
__device__ __forceinline__ unsigned bf_int(int n) { return __builtin_bit_cast(unsigned, (float)n) >> 16; }

template <int MODE>
__device__ __forceinline__ void tile_compute(LAS unsigned char* lds, const LAS unsigned char* kbuf, const LAS unsigned char* vbuf, const int kt, const bool need_mask, const bool sel,
                                             const bf16x8 (&qf)[4], const bf16x8 qaug, const int t, const int ql, const int hg, const int half, const int lane,
                                             float& m_run, float& l_run, f32x16& O0, f32x16& O1, const float inv_l, float& carry) {
    f32x16 s;
#pragma unroll
    for (int r = 0; r < 16; ++r) s[r] = 0.f;
    const LAS unsigned char* kb = kbuf + (lane & 31) * KROW;
#pragma unroll
    for (int ks = 0; ks < 4; ++ks) { const bf16x8 kf = *(const LAS bf16x8*)(kb + half * 16 + ks * 32); s = MFMA32(kf, qf[ks], s); }
    { u32x4 kw = *(const LAS u32x4*)(kb + 128); if (half) kw = (u32x4){0u, 0u, 0u, 0u}; s = MFMA32(__builtin_bit_cast(bf16x8, kw), qaug, s); }
    if (need_mask) {
        constexpr float DSTEP = (MODE == CMP1 || MODE == CMP2) ? 16.f : 1.f;
        const float dl = (MODE == CMP1 || MODE == CMP2) ? (float)(t - 31 - 512 * kt - 64 * half) : (float)(t - 32 * kt - 4 * half);
#pragma unroll
        for (int r = 0; r < 16; ++r) { const float d = dl - DSTEP * (float)((r & 3) + 8 * (r >> 2));
            const bool ok = (MODE == WIN) ? (d >= 0.f && d < 512.f) : (d >= 0.f);
            s[r] = ok ? s[r] : -1e30f; }
    }
    float p[16];
    if (MODE == CMP2) {
#pragma unroll
        for (int r = 0; r < 16; ++r) p[r] = fast_exp2(s[r] - m_run) * inv_l;
    } else {
        float mx = fmaxf(fmaxf(fmaxf(s[0], s[1]), fmaxf(s[2], s[3])), fmaxf(fmaxf(s[4], s[5]), fmaxf(s[6], s[7])));
        mx = fmaxf(mx, fmaxf(fmaxf(fmaxf(s[8], s[9]), fmaxf(s[10], s[11])), fmaxf(fmaxf(s[12], s[13]), fmaxf(s[14], s[15]))));
        if (MODE == SEL) mx = sel ? mx : -1e30f;
        mx = fmaxf(mx, shx(mx, 32, lane));
        if (__ballot(mx > m_run + 8.f) != 0ull) {
            const float m_new = fmaxf(m_run, mx), alpha = fast_exp2(m_run - m_new);
            l_run *= alpha; m_run = m_new;
            if (MODE != CMP1) { O0 = O0 * alpha; O1 = O1 * alpha; }
        }
        const float msub = (MODE == SEL && !sel) ? 1e30f : m_run;
        f32x2 ls2 = {0.f, 0.f};
#pragma unroll
        for (int r = 0; r < 16; r += 2) { const f32x2 sv = {s[r], s[r + 1]}; const f32x2 dv = sv - msub;
            f32x2 pv; pv.x = fast_exp2(dv.x); pv.y = fast_exp2(dv.y); ls2 = ls2 + pv; p[r] = pv.x; p[r + 1] = pv.y; }
        l_run += ls2.x + ls2.y;
    }
    if (MODE != CMP1) {
        u32x4 pa, pb;
        pa.x = pk_bf16(p[0], p[1]); pa.y = pk_bf16(p[2], p[3]); pa.z = pk_bf16(p[4], p[5]); pa.w = pk_bf16(p[6], p[7]);
        pb.x = pk_bf16(p[8], p[9]); pb.y = pk_bf16(p[10], p[11]); pb.z = pk_bf16(p[12], p[13]); pb.w = pk_bf16(p[14], p[15]);
        const bf16x8 P0 = __builtin_bit_cast(bf16x8, pa), P1 = __builtin_bit_cast(bf16x8, pb);
        const LAS unsigned char* vb = vbuf + (lane & 31) * VROW + half * 16;
        const bf16x8 v00 = *(const LAS bf16x8*)(vb), v01 = *(const LAS bf16x8*)(vb + 32);
        const bf16x8 v10 = *(const LAS bf16x8*)(vb + 32 * VROW), v11 = *(const LAS bf16x8*)(vb + 32 * VROW + 32);
        O0 = MFMA32(v00, P0, O0); O0 = MFMA32(v01, P1, O0);
        O1 = MFMA32(v10, P0, O1); O1 = MFMA32(v11, P1, O1);
    }
    if (MODE == CMP2) {
        float mn[4], tl[4];
#pragma unroll
        for (int g = 0; g < 4; ++g) { mn[g] = 2.f * (p[4 * g] + p[4 * g + 1] + p[4 * g + 2]) + p[4 * g + 3]; tl[g] = p[4 * g + 3]; }
#pragma unroll
        for (int g = 0; g < 4; ++g) { mn[g] += shx(mn[g], 8, lane); tl[g] += shx(tl[g], 8, lane); }
#pragma unroll
        for (int g = 0; g < 4; ++g) { mn[g] += shx(mn[g], 16, lane); tl[g] += shx(tl[g], 16, lane); }
        float xg[4];
        xg[0] = shx(half ? carry : tl[0], 32, lane);
        xg[1] = shx(half ? tl[0] : tl[1], 32, lane);
        xg[2] = shx(half ? tl[1] : tl[2], 32, lane);
        xg[3] = shx(half ? tl[2] : tl[3], 32, lane);
        carry = tl[3];
        if (hg == 0) { LAS unsigned* kp = (LAS unsigned*)(lds + OFF_IMP) + ql * IMP_STRIDE;
#pragma unroll
            for (int g = 0; g < 4; ++g) { const int mblk = 8 * kt + 2 * g + half; const float iv = mn[g] + xg[g];
                if (mblk < 128) kp[mblk] = (__builtin_bit_cast(unsigned, iv) & ~127u) | (unsigned)(127 - mblk); } }
    }
}

template <int MODE>
__device__ __forceinline__ void attn_tiles(LAS unsigned char* lds, const int npairs, const bf16_t* Kbase, const bf16_t* Vbase, const int c,
                                           const bf16x8 (&qf)[4], const bf16x8 qaug, const int t, const int ql, const int hg, const int half, const int lane, const int tid,
                                           float& m_run, float& l_run, f32x16& O0, f32x16& O1, const float inv_l) {
    const bool isV = tid >= 256; const int ci = tid & 255;
    const bool stager = (MODE == CMP1) ? !isV : true;
    const bool augw = isV && ci < 64;
    const unsigned ldst = isV ? (unsigned)(OFF_V + (ci >> 2) * VROW + (ci & 3) * 16) : (unsigned)(OFF_K + (ci >> 3) * KROW + (ci & 7) * 16);
    const unsigned tstep = isV ? VT_BYTES : KT_BYTES;
    const unsigned laug = (unsigned)(OFF_K + (ci >> 5) * KT_BYTES + (ci & 31) * KROW + 128);
    const bf16_t* gsrc = (isV ? Vbase : Kbase) + ci * 8;
    float carry = 0.f;
#define BLK_OF(ip) ((MODE == CMP1 || MODE == CMP2) ? (ip) : ((ip) == 0 ? c : c - (ip)))
#define AUG_WORD(blk) ({ const int key_ = 64 * (blk) + ci; const int pos_ = (MODE == CMP1 || MODE == CMP2) ? 16 * key_ + 31 : key_; bf_int(pos_ >> 7) | (bf_int(pos_ & 127) << 16); })
    u32x4 stg0 = {0u, 0u, 0u, 0u}, stg1 = {0u, 0u, 0u, 0u};
    if (stager) { const bf16_t* g0 = gsrc + (size_t)BLK_OF(0) * 4096; stg0 = *(const u32x4*)g0; stg1 = *(const u32x4*)(g0 + 2048); }
    __syncthreads();
    if (stager) { *(LAS u32x4*)(lds + ldst) = stg0; *(LAS u32x4*)(lds + ldst + tstep) = stg1; }
    if (augw) { const unsigned w = AUG_WORD(BLK_OF(0)); *(LAS u32x4*)(lds + laug) = (u32x4){w, w, 0u, 0u}; }
    __syncthreads();
    for (int ip = 0; ip < npairs; ++ip) {
        const int buf = ip & 1, blk = BLK_OF(ip);
        if (ip + 1 < npairs && stager) { const bf16_t* g0 = gsrc + (size_t)BLK_OF(ip + 1) * 4096; stg0 = *(const u32x4*)g0; stg1 = *(const u32x4*)(g0 + 2048); }
        bool active = true, sel = true;
        if (MODE == SEL) {
            const unsigned w = ((const LAS unsigned short*)(lds + OFF_SEL))[ql * 8 + (blk >> 4)];
            sel = (w >> (blk & 15)) & 1u;
            active = __ballot(sel) != 0ull;
        }
        if (active) {
            bool need_mask;
            if (MODE == SEL) need_mask = ip == 0; else if (MODE == WIN) need_mask = (ip == 0) || (ip == 8); else need_mask = true;
#pragma unroll
            for (int sub = 0; sub < 2; ++sub)
                tile_compute<MODE>(lds, lds + OFF_K + (buf * 2 + sub) * KT_BYTES, lds + OFF_V + (buf * 2 + sub) * VT_BYTES, 2 * blk + sub, need_mask, sel,
                                   qf, qaug, t, ql, hg, half, lane, m_run, l_run, O0, O1, inv_l, carry);
        }
        if (ip + 1 < npairs) {
            if (stager) { *(LAS u32x4*)(lds + ldst + (buf ^ 1) * 2 * tstep) = stg0; *(LAS u32x4*)(lds + ldst + (buf ^ 1) * 2 * tstep + tstep) = stg1; }
            if (augw) { const unsigned w = AUG_WORD(BLK_OF(ip + 1)); *(LAS u32x4*)(lds + laug + (buf ^ 1) * 2 * KT_BYTES) = (u32x4){w, w, 0u, 0u}; }
        }
        __syncthreads();
    }
#undef BLK_OF
#undef AUG_WORD
}

__device__ __forceinline__ void attn_unit(LAS unsigned char* lds, const int bg, const int c, const bf16_t* Q, const bf16_t* KV, const bf16_t* KC, const bf16_t* VC,
                                          const float* GATES, bf16_t* O, const unsigned* KMAX, const int tid) {
    const int lane = tid & 63, wave = __builtin_amdgcn_readfirstlane(tid >> 6);
    const int col = lane & 31, half = lane >> 5, hg = col >> 3, ql = wave * 8 + (col & 7);
    const int b = bg >> 2, g = bg & 3, head = g * 4 + hg, t = c * 64 + ql;
    const size_t tok = (size_t)b * SEQ + t;
    const float sl2 = fast_exp2(-0.5f * (float)(head + 1)) * 1.4426950408889634f;
    bf16x8 qaug;
    { const float shf = bf_lo(pk_bf16(sl2, 0.f)), slo = sl2 - shf;
      u32x4 qa = {pk_bf16(shf * 128.f, shf), pk_bf16(slo * 128.f, slo), 0u, 0u}; if (half) qa = (u32x4){0u, 0u, 0u, 0u};
      qaug = __builtin_bit_cast(bf16x8, qa); }
    bf16x8 qf[4];
    { const bf16_t* qp = Q + tok * 1024 + head * 64 + half * 8;
#pragma unroll
      for (int ks = 0; ks < 4; ++ks) qf[ks] = *(const bf16x8*)(qp + ks * 16); }
    int blk_lo;
    { float qn2 = 0.f;
#pragma unroll
      for (int ks = 0; ks < 4; ++ks) { const u32x4 w = __builtin_bit_cast(u32x4, qf[ks]);
          qn2 += (bf_lo(w.x) * bf_lo(w.x) + bf_hi(w.x) * bf_hi(w.x)) + (bf_lo(w.y) * bf_lo(w.y) + bf_hi(w.y) * bf_hi(w.y));
          qn2 += (bf_lo(w.z) * bf_lo(w.z) + bf_hi(w.z) * bf_hi(w.z)) + (bf_lo(w.w) * bf_lo(w.w) + bf_hi(w.w) * bf_hi(w.w)); }
      qn2 += shx(qn2, 32, lane);
#pragma unroll
      for (int o = 1; o < 32; o <<= 1) qn2 = fmaxf(qn2, shx(qn2, o, lane));
      LAS float* qx = (LAS float*)(lds + OFF_SEL);
      __syncthreads();
      if (lane == 0) qx[wave] = qn2;
      __syncthreads();
      float qm2 = qx[0];
#pragma unroll
      for (int w8 = 1; w8 < 8; ++w8) qm2 = fmaxf(qm2, qx[w8]);
      const float km2 = __builtin_bit_cast(float, KMAX[bg]);
      const float sl2min = fast_exp2(-0.5f * (float)(4 * g + 4)) * 1.4426950408889634f;
      const float D = (150.f + 2.f * __builtin_amdgcn_sqrtf(qm2 * km2) * 1.01f) / sl2min;
      const float lim = (float)(64 * c) - D - 63.f;
      blk_lo = (lim >= 0.f) ? ((int)(lim * (1.f / 64.f)) + 1) : 0;
      blk_lo = __builtin_amdgcn_readfirstlane(blk_lo < c ? blk_lo : c);
      __syncthreads(); }
    const float* gp = GATES + tok * 48 + head * 3;
    const float g_c = gp[0], g_s = gp[1], g_w = gp[2];
    f32x16 O0, O1;
    LAS float* otp = (LAS float*)(lds + OFF_OT) + tid;
#pragma unroll
    for (int r = 0; r < 16; ++r) { O0[r] = 0.f; O1[r] = 0.f; }
    const bf16_t* Kc = KC + (size_t)bg * 512 * 64; const bf16_t* Vc = VC + (size_t)bg * 16 * 2048;
    const bf16_t* Ks = KV + 2 * KV_ELEMS + (size_t)bg * SEQ * 64; const bf16_t* Vs = KV + 3 * KV_ELEMS + (size_t)bg * SEQ * 64;
    const bf16_t* Kw = KV + 4 * KV_ELEMS + (size_t)bg * SEQ * 64; const bf16_t* Vw = KV + 5 * KV_ELEMS + (size_t)bg * SEQ * 64;

    const int ntc = (4 * c + 3 + 63) >> 6;
    float m_c = -1e30f, l_c = 0.f;
    attn_tiles<CMP1>(lds, ntc, Kc, Vc, c, qf, qaug, t, ql, hg, half, lane, tid, m_c, l_c, O0, O1, 0.f);
    l_c += shx(l_c, 32, lane);
    const float inv_c = (m_c > -1e29f) ? fast_rcp(fmaxf(l_c, 1e-30f)) : 0.f;
    attn_tiles<CMP2>(lds, ntc, Kc, Vc, c, qf, qaug, t, ql, hg, half, lane, tid, m_c, l_c, O0, O1, inv_c);
#pragma unroll
    for (int r = 0; r < 16; ++r) { otp[512 * r] = g_c * O0[r]; otp[512 * (16 + r)] = g_c * O1[r]; O0[r] = 0.f; O1[r] = 0.f; }
    { const int q = tid >> 3, part = tid & 7; unsigned bits = 0u;
      const LAS unsigned* keys = (const LAS unsigned*)(lds + OFF_IMP) + q * IMP_STRIDE;
      if (c < 16) {
#pragma unroll
          for (int e = 0; e < 16; ++e) if (part * 16 + e <= c) bits |= 1u << e;
      } else {
          unsigned ck[16];
#pragma unroll
          for (int e = 0; e < 16; ++e) { const int jb = part * 16 + e; ck[e] = (jb >= 1 && jb <= c - 2) ? keys[jb] : 0u; }
#pragma unroll 1
          for (int it = 0; it < 13; ++it) {
              unsigned m01 = ck[0] > ck[1] ? ck[0] : ck[1], m23 = ck[2] > ck[3] ? ck[2] : ck[3], m45 = ck[4] > ck[5] ? ck[4] : ck[5], m67 = ck[6] > ck[7] ? ck[6] : ck[7];
              unsigned m89 = ck[8] > ck[9] ? ck[8] : ck[9], mab = ck[10] > ck[11] ? ck[10] : ck[11], mcd = ck[12] > ck[13] ? ck[12] : ck[13], mef = ck[14] > ck[15] ? ck[14] : ck[15];
              m01 = m01 > m23 ? m01 : m23; m45 = m45 > m67 ? m45 : m67; m89 = m89 > mab ? m89 : mab; mcd = mcd > mef ? mcd : mef;
              m01 = m01 > m45 ? m01 : m45; m89 = m89 > mcd ? m89 : mcd;
              unsigned m = m01 > m89 ? m01 : m89;
              { const unsigned o = (unsigned)__builtin_amdgcn_update_dpp(0, (int)m, 0xB1, 0xf, 0xf, true); m = m > o ? m : o; }
              { const unsigned o = (unsigned)__builtin_amdgcn_update_dpp(0, (int)m, 0x4E, 0xf, 0xf, true); m = m > o ? m : o; }
              { const unsigned o = (unsigned)__builtin_amdgcn_update_dpp(0, (int)m, 0x141, 0xf, 0xf, true); m = m > o ? m : o; }
#pragma unroll
              for (int e = 0; e < 16; ++e) ck[e] = (ck[e] == m) ? 0u : ck[e];
          }
#pragma unroll
          for (int e = 0; e < 16; ++e) { const int jb = part * 16 + e;
              const bool forced = (jb == 0) || (jb == c) || (jb == c - 1);
              const bool cand = (jb >= 1) && (jb <= c - 2) && (ck[e] == 0u);
              if (forced || cand) bits |= 1u << e; }
      }
      ((LAS unsigned short*)(lds + OFF_SEL))[q * 8 + part] = (unsigned short)bits; }
    float m_s = -1e30f, l_s = 0.f;
    attn_tiles<SEL>(lds, c + 1 - blk_lo, Ks, Vs, c, qf, qaug, t, ql, hg, half, lane, tid, m_s, l_s, O0, O1, 0.f);
    l_s += shx(l_s, 32, lane);
    { const float f = g_s * fast_rcp(fmaxf(l_s, 1e-30f));
#pragma unroll
      for (int r = 0; r < 16; ++r) { otp[512 * r] += f * O0[r]; otp[512 * (16 + r)] += f * O1[r]; O0[r] = 0.f; O1[r] = 0.f; } }
    float m_w = -1e30f, l_w = 0.f;
    attn_tiles<WIN>(lds, 1 + (c < 8 ? c : 8), Kw, Vw, c, qf, qaug, t, ql, hg, half, lane, tid, m_w, l_w, O0, O1, 0.f);
    l_w += shx(l_w, 32, lane);
    f32x16 ot0, ot1;
    { const float f = g_w * fast_rcp(fmaxf(l_w, 1e-30f));
#pragma unroll
      for (int r = 0; r < 16; ++r) { ot0[r] = otp[512 * r] + f * O0[r]; ot1[r] = otp[512 * (16 + r)] + f * O1[r]; } }
    bf16_t* op = O + tok * 1024 + head * 64 + 4 * half;
#pragma unroll
    for (int gq = 0; gq < 4; ++gq) {
        u32x2 w0, w1; w0.x = pk_bf16(ot0[4 * gq], ot0[4 * gq + 1]); w0.y = pk_bf16(ot0[4 * gq + 2], ot0[4 * gq + 3]);
        w1.x = pk_bf16(ot1[4 * gq], ot1[4 * gq + 1]); w1.y = pk_bf16(ot1[4 * gq + 2], ot1[4 * gq + 3]);
        *(u32x2*)(op + 8 * gq) = w0; *(u32x2*)(op + 32 + 8 * gq) = w1; }
}
}

struct Params {
    const float* in[24]; float* out; unsigned char* ws; int ph_lo, ph_hi;
};

__device__ __forceinline__ void transpose_item(const float* src, int ld, int nvalid, int K, bf16_t* dst, int item, int nblk, LAS float* scr, int lane, const float* gk = nullptr) {
    const int kb = item / nblk, nb = item % nblk, k0 = 64 * kb, n0 = 32 * nb;
    const int n = n0 + (lane & 31);
#pragma unroll
    for (int i = 0; i < 32; ++i) { const int kk = 2 * i + (lane >> 5); scr[kk * 33 + (lane & 31)] = (n < nvalid) ? src[(size_t)(k0 + kk) * ld + n] * (gk ? gk[k0 + kk] : 1.f) : 0.f; }
    asm volatile("s_waitcnt lgkmcnt(0)" ::: "memory");
    const int cc = lane & 7;
#pragma unroll
    for (int j = 0; j < 4; ++j) { const int nn = (lane >> 3) + 8 * j; const LAS float* s = scr + (8 * cc) * 33 + nn;
        u32x4 o; o.x = pk_bf16(s[0], s[33]); o.y = pk_bf16(s[2 * 33], s[3 * 33]); o.z = pk_bf16(s[4 * 33], s[5 * 33]); o.w = pk_bf16(s[6 * 33], s[7 * 33]);
        *(u32x4*)(dst + (size_t)(n0 + nn) * K + k0 + 8 * cc) = o; }
    asm volatile("s_waitcnt lgkmcnt(0)" ::: "memory");
}

__device__ __forceinline__ void prep_phase(const __attribute__((address_space(4))) Params* Pq, LAS unsigned char* lds, const int tid, const int bx, const int G) {
    const int lane = tid & 63, wave = tid >> 6;
    LAS float* scr = (LAS float*)(lds + wave * 16384);
    const int gw = bx * 8 + wave, NGW = G * 8;
    unsigned char* ws = Pq->ws;
    constexpr int I_UP = 16 * 128, I_DN = 64 * 32, I_RGIN = 16 * 64, I_SQ = 16 * 32, I_GATE = 256, I_NSAIN = 16 * (NSA_NPAD / 32), I_W1 = 32 * 8;
    constexpr int NITEMS = 4 * I_UP + 4 * I_DN + 2 * I_RGIN + 2 * I_SQ + 2 * I_GATE + 2 * I_NSAIN + 2 * I_SQ + 4 * I_W1;
    for (int it = gw; it < NITEMS; it += NGW) {
        int r = it;
        if (r < 4 * I_UP) { const int L = r / I_UP; transpose_item(Pq->in[22] + (size_t)L * 1024 * 4096, 4096, 4096, 1024, (bf16_t*)(ws + W_UP) + (size_t)L * 4096 * 1024, r % I_UP, 128, scr, lane, Pq->in[2] + (size_t)L * 1024); continue; } r -= 4 * I_UP;
        if (r < 4 * I_DN) { const int L = r / I_DN; transpose_item(Pq->in[23] + (size_t)L * 4096 * 1024, 1024, 1024, 4096, (bf16_t*)(ws + W_DN) + (size_t)L * 1024 * 4096, r % I_DN, 32, scr, lane); continue; } r -= 4 * I_DN;
        if (r < 2 * I_RGIN) { const int j = r / I_RGIN; transpose_item(Pq->in[4] + (size_t)j * 1024 * 2048, 2048, 2048, 1024, (bf16_t*)(ws + W_RGIN) + (size_t)j * 2048 * 1024, r % I_RGIN, 64, scr, lane, Pq->in[1] + (size_t)(2 * j) * 1024); continue; } r -= 2 * I_RGIN;
        if (r < 2 * I_SQ) { const int j = r / I_SQ; transpose_item(Pq->in[12] + (size_t)j * 1024 * 1024, 1024, 1024, 1024, (bf16_t*)(ws + W_RGOUT) + (size_t)j * 1024 * 1024, r % I_SQ, 32, scr, lane); continue; } r -= 2 * I_SQ;
        if (r < 2 * I_GATE) { const int j = r / I_GATE, rr = r % I_GATE, sub = rr >> 4, pn = sub >> 1, bj = sub & 1, blk = pn >> 1;
            const float* src = (bj ? Pq->in[9] : Pq->in[7]) + ((size_t)(j * 4 + blk) * 256 * 256) + 128 * (pn & 1);
            transpose_item(src, 256, 128, 256, (bf16_t*)(ws + W_RGGATE) + (size_t)j * 2048 * 256 + (size_t)(256 * pn + 128 * bj) * 256, rr & 15, 4, scr, lane); continue; } r -= 2 * I_GATE;
        if (r < 2 * I_NSAIN) { const int j = r / I_NSAIN; transpose_item(Pq->in[13] + (size_t)j * 1024 * NSA_N, NSA_N, NSA_N, 1024, (bf16_t*)(ws + W_NSAIN + (size_t)j * NSAIN_BYTES), r % I_NSAIN, NSA_NPAD / 32, scr, lane, Pq->in[1] + (size_t)(2 * j + 1) * 1024); continue; } r -= 2 * I_NSAIN;
        if (r < 2 * I_SQ) { const int j = r / I_SQ; transpose_item(Pq->in[21] + (size_t)j * 1024 * 1024, 1024, 1024, 1024, (bf16_t*)(ws + W_NSAOUT) + (size_t)j * 1024 * 1024, r % I_SQ, 32, scr, lane); continue; } r -= 2 * I_SQ;
        { const int q = r / I_W1, j = q >> 1, kv = q & 1; transpose_item(Pq->in[kv ? 19 : 17] + (size_t)j * 2048 * 64, 64, 64, 2048, (bf16_t*)(ws + W_W1) + (size_t)q * 256 * 2048, r % I_W1, 8, scr, lane); }
    }
    { bf16_t* X16 = (bf16_t*)(ws + WS_HB); float* PART = (float*)(ws + WS_PART); const float* X = Pq->in[0];
      for (int row = gw; row < T_TOK; row += NGW) { const float* xr = X + (size_t)row * 1024 + 4 * lane; float ssq = 0.f;
#pragma unroll
          for (int q = 0; q < 4; ++q) { const f32x4 v = *(const f32x4*)(xr + 256 * q); u32x2 w; w.x = pk_bf16(v.x, v.y); w.y = pk_bf16(v.z, v.w);
              *(u32x2*)(X16 + (size_t)row * 1024 + 4 * lane + 256 * q) = w;
              ssq += (bf_lo(w.x) * bf_lo(w.x) + bf_hi(w.x) * bf_hi(w.x)) + (bf_lo(w.y) * bf_lo(w.y) + bf_hi(w.y) * bf_hi(w.y)); }
          ssq = wave_sum(ssq, lane);
          if (lane < 16) PART[(size_t)row * 16 + lane] = (lane == 0) ? ssq : 0.f; } }
    for (int o = gw; o < 256; o += NGW) { const int j = o >> 7, kv = (o >> 6) & 1, n = o & 63;
        const float* pe = Pq->in[kv ? 16 : 15] + (size_t)j * 2048; const float* w1 = Pq->in[kv ? 19 : 17] + (size_t)j * 2048 * 64;
        float s = 0.f;
        for (int f = lane; f < 2048; f += 64) s += pe[f] * w1[(size_t)f * 64 + n];
        s = wave_sum(s, lane);
        if (lane == 0) ((float*)(ws + WS_C1))[o] = s; }
}

__device__ __forceinline__ void final_norm_phase(const bf16_t* X16, const float* gam, float* OUT, const int tid, const int bx, const int G) {
    const int lane = tid & 63, gw = bx * 8 + (tid >> 6), NGW = G * 8;
    for (int row = gw; row < T_TOK; row += NGW) {
        const u32x4 w0 = *(const u32x4*)(X16 + (size_t)row * 1024 + 8 * lane), w1 = *(const u32x4*)(X16 + (size_t)row * 1024 + 512 + 8 * lane);
        float v[16] = {bf_lo(w0.x), bf_hi(w0.x), bf_lo(w0.y), bf_hi(w0.y), bf_lo(w0.z), bf_hi(w0.z), bf_lo(w0.w), bf_hi(w0.w),
                       bf_lo(w1.x), bf_hi(w1.x), bf_lo(w1.y), bf_hi(w1.y), bf_lo(w1.z), bf_hi(w1.z), bf_lo(w1.w), bf_hi(w1.w)};
        float s = 0.f;
#pragma unroll
        for (int e = 0; e < 16; ++e) s += v[e] * v[e];
        const float rs = __builtin_amdgcn_rsqf(wave_sum(s, lane) * (1.f / 1024.f) + 1e-6f);
#pragma unroll
        for (int h = 0; h < 2; ++h) { const float* gp = gam + 512 * h + 8 * lane; float* op = OUT + (size_t)row * 1024 + 512 * h + 8 * lane;
            const f32x4 g0 = *(const f32x4*)gp, g1 = *(const f32x4*)(gp + 4);
            *(f32x4*)op = (f32x4){v[8 * h] * rs * g0.x, v[8 * h + 1] * rs * g0.y, v[8 * h + 2] * rs * g0.z, v[8 * h + 3] * rs * g0.w};
            *(f32x4*)(op + 4) = (f32x4){v[8 * h + 4] * rs * g1.x, v[8 * h + 5] * rs * g1.y, v[8 * h + 6] * rs * g1.z, v[8 * h + 7] * rs * g1.w}; }
    }
}

__device__ __forceinline__ void conv_phase(const bf16_t* XPRE, const float* cw, const float* cb, bf16_t* XB, const int tid, const int bx, const int G) {
    const int gt = bx * NTHREADS + tid, NT = G * NTHREADS;
    for (int idx = gt; idx < 2048 * 128; idx += NT) {
        const int ch0 = (idx & 127) * 8, t0 = (idx >> 7) * 16;
        float w[4][8], bb[8], h[3][8];
#pragma unroll
        for (int e = 0; e < 8; ++e) { bb[e] = cb[ch0 + e];
#pragma unroll
            for (int k = 0; k < 4; ++k) w[k][e] = cw[k * 1024 + ch0 + e]; }
        const bool first = (t0 & 8191) == 0;
#pragma unroll
        for (int k = 0; k < 3; ++k) { u32x4 xw = {0u, 0u, 0u, 0u};
            if (!first) xw = *(const u32x4*)(XPRE + (size_t)(t0 - 3 + k) * 1024 + ch0);
            h[k][0] = bf_lo(xw.x); h[k][1] = bf_hi(xw.x); h[k][2] = bf_lo(xw.y); h[k][3] = bf_hi(xw.y); h[k][4] = bf_lo(xw.z); h[k][5] = bf_hi(xw.z); h[k][6] = bf_lo(xw.w); h[k][7] = bf_hi(xw.w); }
        u32x4 xrow[16];
#pragma unroll
        for (int i = 0; i < 16; ++i) xrow[i] = *(const u32x4*)(XPRE + (size_t)(t0 + i) * 1024 + ch0);
#pragma unroll
        for (int i = 0; i < 16; ++i) {
            const u32x4 xw = xrow[i];
            float x[8] = {bf_lo(xw.x), bf_hi(xw.x), bf_lo(xw.y), bf_hi(xw.y), bf_lo(xw.z), bf_hi(xw.z), bf_lo(xw.w), bf_hi(xw.w)};
            float y[8];
#pragma unroll
            for (int e = 0; e < 8; ++e) { y[e] = bb[e] + w[0][e] * h[0][e] + w[1][e] * h[1][e] + w[2][e] * h[2][e] + w[3][e] * x[e]; h[0][e] = h[1][e]; h[1][e] = h[2][e]; h[2][e] = x[e]; }
            u32x4 o; o.x = pk_bf16(y[0], y[1]); o.y = pk_bf16(y[2], y[3]); o.z = pk_bf16(y[4], y[5]); o.w = pk_bf16(y[6], y[7]);
            *(u32x4*)(XB + (size_t)(t0 + i) * 1024 + ch0) = o; }
    }
}

template <bool FINAL>
__device__ __forceinline__ void scan_chunk_phase(const bf16_t* A, const bf16_t* U, const bf16_t* Y, float* SUMP, float* SUMH, const float* CARRY, bf16_t* HY, const int tid, const int bx, const int G) {
    const int gt = bx * NTHREADS + tid, NT = G * NTHREADS;
    for (int idx = gt; idx < 4 * 128 * 512; idx += NT) {
        const int chp = idx & 511, bk = idx >> 9;
        const size_t t0 = (size_t)bk * 64;
        float h0 = 0.f, h1 = 0.f, p0 = 1.f, p1 = 1.f;
        if (FINAL) { const f32x2 cv = *(const f32x2*)(CARRY + (size_t)bk * 1024 + 2 * chp); h0 = cv.x; h1 = cv.y; }
#pragma unroll 1
        for (int i0 = 0; i0 < 64; i0 += 16) {
            unsigned awv[16], uwv[16], ywv[16];
#pragma unroll
            for (int q = 0; q < 16; ++q) { const size_t o = (t0 + i0 + q) * 1024 + 2 * chp; awv[q] = *(const unsigned*)(A + o); uwv[q] = *(const unsigned*)(U + o); ywv[q] = FINAL ? *(const unsigned*)(Y + o) : 0u; }
#pragma unroll
            for (int q = 0; q < 16; ++q) { const size_t o = (t0 + i0 + q) * 1024 + 2 * chp; const f32x2 a = {1.f - bf_lo(awv[q]), 1.f - bf_hi(awv[q])};
                h0 = a.x * h0 + bf_lo(uwv[q]); h1 = a.y * h1 + bf_hi(uwv[q]);
                if (FINAL) *(unsigned*)(HY + o) = pk_bf16(h0 * bf_lo(ywv[q]), h1 * bf_hi(ywv[q]));
                else { p0 *= a.x; p1 *= a.y; } } }
        if (!FINAL) { *(f32x2*)(SUMP + (size_t)bk * 1024 + 2 * chp) = (f32x2){p0, p1}; *(f32x2*)(SUMH + (size_t)bk * 1024 + 2 * chp) = (f32x2){h0, h1}; }
    }
}
__device__ __forceinline__ void scan_carry_phase(const float* SUMP, const float* SUMH, float* CARRY, LAS unsigned char* lds, const int tid, const int bx) {
    if (bx >= 64) return;
    const int seg = tid >> 6, chl = tid & 63, b = bx >> 4, ch = (bx & 15) * 64 + chl;
    float pv[16], hv[16];
#pragma unroll
    for (int q = 0; q < 16; ++q) { const size_t o = (size_t)(b * 128 + seg * 16 + q) * 1024 + ch; pv[q] = SUMP[o]; hv[q] = SUMH[o]; }
    float Pc = 1.f, Hc = 0.f;
#pragma unroll
    for (int q = 0; q < 16; ++q) { Hc = pv[q] * Hc + hv[q]; Pc *= pv[q]; }
    LAS float* ex = (LAS float*)lds;
    ex[seg * 64 + chl] = Pc; ex[512 + seg * 64 + chl] = Hc;
    __syncthreads();
    float h = 0.f;
    for (int sgi = 0; sgi < seg; ++sgi) h = ex[sgi * 64 + chl] * h + ex[512 + sgi * 64 + chl];
#pragma unroll
    for (int q = 0; q < 16; ++q) { const size_t o = (size_t)(b * 128 + seg * 16 + q) * 1024 + ch; CARRY[o] = h; h = pv[q] * h + hv[q]; }
}

__device__ __forceinline__ void cmp_w2_phase(const bf16_t* MID, const float* w2k, const float* w2v, bf16_t* KC, bf16_t* VC, const bf16_t* KS, unsigned* KMAX, const int tid, const int bx, const int G) {
    const int gt = bx * NTHREADS + tid, NT = G * NTHREADS;
    for (int r = gt; r < 16 * SEQ; r += NT) {
        const u32x4* kp = (const u32x4*)(KS + (size_t)r * 64); float n2 = 0.f;
#pragma unroll
        for (int q = 0; q < 8; ++q) { const u32x4 w = kp[q];
            n2 += (bf_lo(w.x) * bf_lo(w.x) + bf_hi(w.x) * bf_hi(w.x)) + (bf_lo(w.y) * bf_lo(w.y) + bf_hi(w.y) * bf_hi(w.y));
            n2 += (bf_lo(w.z) * bf_lo(w.z) + bf_hi(w.z) * bf_hi(w.z)) + (bf_lo(w.w) * bf_lo(w.w) + bf_hi(w.w) * bf_hi(w.w)); }
#pragma unroll
        for (int o = 1; o < 64; o <<= 1) n2 = fmaxf(n2, shx(n2, o, tid & 63));
        if ((tid & 63) == 0) atomicMax(KMAX + (r >> 13), __builtin_bit_cast(unsigned, n2));
    }
    for (int idx = gt; idx < 2 * 8192 * 64; idx += NT) {
        const int which = idx >> 19, rem = idx & ((1 << 19) - 1), row = rem >> 6, n = rem & 63;
        const bf16_t* mid = MID + (size_t)which * 8192 * 64 + (size_t)row * 64; const float* w2 = which ? w2v : w2k;
        float s = 0.f;
#pragma unroll
        for (int k8 = 0; k8 < 8; ++k8) { const u32x4 mw = *(const u32x4*)(mid + 8 * k8);
            const float mv[8] = {bf_lo(mw.x), bf_hi(mw.x), bf_lo(mw.y), bf_hi(mw.y), bf_lo(mw.z), bf_hi(mw.z), bf_lo(mw.w), bf_hi(mw.w)};
#pragma unroll
            for (int e = 0; e < 8; ++e) s += mv[e] * w2[(8 * k8 + e) * 64 + n]; }
        const bf16_t o = (bf16_t)(pk_bf16(s, 0.f) & 0xffff);
        if (which == 0) KC[(size_t)row * 64 + n] = o;
        else { const int bg = row >> 9, j = row & 511; VC[(size_t)(bg * 16 + (j >> 5)) * 2048 + n * 32 + vslot(j & 31)] = o; }
    }
}

__device__ __forceinline__ int get_tid(int wave_s) {
    int lane; asm volatile("v_mbcnt_lo_u32_b32 %0, -1, 0\n\tv_mbcnt_hi_u32_b32 %0, -1, %0" : "=v"(lane));
    return wave_s * 64 + lane;
}
__device__ __forceinline__ void grid_barrier(unsigned* ctr, unsigned target, int tid) {
    __syncthreads();
    if (tid == 0) {
        __hip_atomic_fetch_add(ctr, 1u, __ATOMIC_RELEASE, __HIP_MEMORY_SCOPE_AGENT);
        while (__hip_atomic_load(ctr, __ATOMIC_RELAXED, __HIP_MEMORY_SCOPE_AGENT) < target) __builtin_amdgcn_s_sleep(1);
        __builtin_amdgcn_fence(__ATOMIC_ACQUIRE, "agent");
    }
    __syncthreads();
}
typedef const __attribute__((address_space(4))) Params* ParamsPtr;
__global__ void __launch_bounds__(NTHREADS, 2) mk_fwd(Params P) {
    extern __shared__ __attribute__((aligned(16))) unsigned char lds_raw[];
    LAS unsigned char* lds = (LAS unsigned char*)lds_raw;
    const int wave_s = __builtin_amdgcn_readfirstlane((int)threadIdx.x >> 6);
    const int lo = P.ph_lo, hi = P.ph_hi;
    if (lo < 0) cg::this_grid().sync();
    int ph = 0; unsigned nbar = 0;
#define PHASE_BEGIN if (ph >= lo && ph < hi) { ParamsPtr Pp = (ParamsPtr)__builtin_amdgcn_kernarg_segment_ptr(); asm volatile("" : "+s"(Pp)); \
        unsigned char* const ws = Pp->ws; int G = gridDim.x, bx = blockIdx.x; asm volatile("" : "+s"(G), "+s"(bx)); const int tid = get_tid(wave_s); (void)G; (void)bx; (void)tid;
#define PHASE_END   if (ph + 1 < hi) { ++nbar; grid_barrier((unsigned*)(ws + WS_BAR), nbar * (unsigned)G, get_tid(wave_s)); } } ++ph;
#define HB_   ((bf16_t*)(ws + WS_HB))
#define XB_   ((bf16_t*)(ws + WS_XB))
#define PART_ ((float*)(ws + WS_PART))
#define XPRE_ ((bf16_t*)(ws + WS_XPRE))
#define BIG_  ((bf16_t*)(ws + WS_BIG))

    PHASE_BEGIN prep_phase(Pp, lds, tid, bx, G); __syncthreads(); PHASE_END

#pragma unroll 1
    for (int L = 0; L < 4; ++L) {
        const int j = L >> 1; const bool nsa = L & 1;
#pragma unroll 1
        for (int sub = 0; sub < 2; ++sub) {
            if (sub == 0 && !nsa) {
                PHASE_BEGIN { pg8::Gemm g{HB_, (const bf16_t*)(ws + W_RGIN) + (size_t)j * 2048 * 1024, 1024, 1024, 1024, 1, 0}; pg8::StaticOrder S; S.init(T_TOK, 2048, G, bx);
                    pg8::EpiRgIn E{ws}; pg8::gemm_phase(lds, tid, g, S, E); } PHASE_END
                PHASE_BEGIN conv_phase(XPRE_, Pp->in[5] + (size_t)j * 4096, Pp->in[6] + (size_t)j * 1024, XB_, tid, bx, G); PHASE_END
                PHASE_BEGIN { pg8::Gemm g{XB_, (const bf16_t*)(ws + W_RGGATE) + (size_t)j * 2048 * 256, 1024, 256, 256, 2, 256}; pg8::StaticOrder S; S.init(T_TOK, 2048, G, bx);
                    pg8::EpiGates E{ws, Pp->in[8] + (size_t)j * 1024, Pp->in[10] + (size_t)j * 1024, Pp->in[11] + (size_t)j * 1024};
                    pg8::gemm_phase(lds, tid, g, S, E); } PHASE_END
                PHASE_BEGIN scan_carry_phase((const float*)(ws + WS_SUMP), (const float*)(ws + WS_SUMH), (float*)(ws + WS_CARRY), lds, tid, bx); __syncthreads(); PHASE_END
                PHASE_BEGIN scan_chunk_phase<true>((const bf16_t*)(ws + WS_A), (const bf16_t*)(ws + WS_U), (const bf16_t*)(ws + WS_Y), nullptr, nullptr, (const float*)(ws + WS_CARRY), XPRE_, tid, bx, G); PHASE_END
            } else if (sub == 0) {
                PHASE_BEGIN { pg8::Gemm g{HB_, (const bf16_t*)(ws + W_NSAIN + (size_t)j * NSAIN_BYTES), 1024, 1024, 1024, 1, 0}; pg8::StaticOrder S; S.init(T_TOK, NSA_NPAD, G, bx);
                    pg8::EpiNsaIn E{ws, Pp->in[14] + (size_t)j * 48};
                    pg8::gemm_phase(lds, tid, g, S, E); } PHASE_END
                PHASE_BEGIN {
#pragma unroll 1
                    for (int kv = 0; kv < 2; ++kv) { pg8::Gemm g{(const bf16_t*)(ws + WS_KV) + (size_t)kv * KV_ELEMS, (const bf16_t*)(ws + W_W1) + (size_t)(j * 2 + kv) * 256 * 2048, 1024, 2048, 2048, 1, 0};
                        pg8::StaticOrder S; S.init(8192, 256, G, (bx + kv * (G / 2)) % G);
                        pg8::EpiCmp E{(bf16_t*)(ws + WS_MID) + (size_t)kv * 8192 * 64, (const float*)(ws + WS_C1) + (j * 2 + kv) * 64};
                        pg8::gemm_phase(lds, tid, g, S, E); } } PHASE_END
                PHASE_BEGIN cmp_w2_phase((const bf16_t*)(ws + WS_MID), Pp->in[18] + (size_t)j * 4096, Pp->in[20] + (size_t)j * 4096, (bf16_t*)(ws + WS_KC), (bf16_t*)(ws + WS_VC), (const bf16_t*)(ws + WS_KV) + 2 * KV_ELEMS, (unsigned*)(ws + WS_KMAX), tid, bx, G); PHASE_END
                PHASE_BEGIN {
                    const int nrounds = (2048 + G - 1) / G;
#pragma unroll 1
                    for (int r = 0; r < nrounds; ++r) { const int idx = r * G + ((r & 1) ? (G - 1 - bx) : bx);
                        if (idx < 2048) att::attn_unit(lds, (((idx & 7) << 1) | ((idx >> 3) & 1))  , 127 - (idx >> 4), (const bf16_t*)(ws + WS_Q), (const bf16_t*)(ws + WS_KV), (const bf16_t*)(ws + WS_KC), (const bf16_t*)(ws + WS_VC), (const float*)(ws + WS_GATE), XPRE_, (const unsigned*)(ws + WS_KMAX), tid); }
                    __syncthreads(); } PHASE_END
            } else {
                PHASE_BEGIN { pg8::Gemm g{HB_, (const bf16_t*)(ws + W_UP) + (size_t)L * 4096 * 1024, 1024, 1024, 1024, 1, 0}; pg8::StaticOrder S; S.init(T_TOK, 4096, G, bx, (G == 256) ? 1 : 0);
                    pg8::EpiRelu2 E{ws}; pg8::gemm_phase(lds, tid, g, S, E); } PHASE_END
            }
            PHASE_BEGIN { const bf16_t* Bt = (sub == 1) ? (const bf16_t*)(ws + W_DN) + (size_t)L * 1024 * 4096 : (nsa ? (const bf16_t*)(ws + W_NSAOUT) : (const bf16_t*)(ws + W_RGOUT)) + (size_t)j * 1024 * 1024;
                const int K = (sub == 1) ? 4096 : 1024;
                pg8::Gemm g{(sub == 1) ? BIG_ : XPRE_, Bt, K, K, K, 1, 0}; pg8::StaticOrder S; S.init(T_TOK, 1024, G, bx);
                pg8::EpiResid E{ws}; pg8::gemm_phase(lds, tid, g, S, E); } PHASE_END
        }
    }
    PHASE_BEGIN final_norm_phase(HB_, Pp->in[3], Pp->out, tid, bx, G); PHASE_END
#undef PHASE_BEGIN
#undef PHASE_END
}
constexpr int NPHASES = 1 + 2 * 8 + 2 * 7 + 1;

extern "C" void kernel_launch(void* const* d_in, const int* in_sizes, int n_in, void* d_out, int out_size, void* d_ws, size_t ws_size, hipStream_t stream) {
    static int grid = 0;
    if (grid == 0) {
        if (n_in != 24 || out_size != T_TOK * DM || ws_size < WS_END) { fprintf(stderr, "kernel_launch: unexpected shapes (n_in %d out %d ws %zu)\n", n_in, out_size, ws_size); grid = -1; return; }
        int dev = 0, cus = 0, per_cu = 0;
        hipGetDevice(&dev); hipDeviceGetAttribute(&cus, hipDeviceAttributeMultiprocessorCount, dev);
        if (hipFuncSetAttribute((const void*)mk_fwd, hipFuncAttributeMaxDynamicSharedMemorySize, LDS_BYTES) != hipSuccess) { fprintf(stderr, "kernel_launch: hipFuncSetAttribute failed\n"); grid = -1; return; }
        if (hipOccupancyMaxActiveBlocksPerMultiprocessor(&per_cu, (const void*)mk_fwd, NTHREADS, LDS_BYTES) != hipSuccess || per_cu < 1) { fprintf(stderr, "kernel_launch: occupancy query says %d\n", per_cu); per_cu = 1; }
        (void)hipGetLastError();
        grid = cus;
    }
    if (grid < 0) return;
    if (hipMemsetAsync((char*)d_ws + WS_BAR, 0, 256, stream) != hipSuccess) { fprintf(stderr, "kernel_launch: memset failed\n"); return; }
    Params p{};
    for (int i = 0; i < 24; ++i) p.in[i] = (const float*)d_in[i];
    p.out = (float*)d_out; p.ws = (unsigned char*)d_ws;
#if MK_MULTI
    for (int ph = 0; ph < NPHASES; ++ph) { p.ph_lo = ph; p.ph_hi = ph + 1; hipLaunchKernelGGL(mk_fwd, dim3(grid), dim3(NTHREADS), LDS_BYTES, stream, p); }
#else
    p.ph_lo = 0; p.ph_hi = NPHASES;
    void* args[] = {&p};
    hipError_t e = hipLaunchCooperativeKernel((const void*)mk_fwd, dim3(grid), dim3(NTHREADS), args, LDS_BYTES, stream);
    if (e != hipSuccess) fprintf(stderr, "cooperative launch failed: %s (grid %d)\n", hipGetErrorString(e), grid);
#endif
}
```

```cpp
#include <hip/hip_runtime.h>
#include <hip/hip_cooperative_groups.h>
#include <cstdio>
#include <cstdint>
namespace cg = cooperative_groups;

#define LAS __attribute__((address_space(3)))
typedef unsigned short bf16_t;
typedef short bf16x8 __attribute__((ext_vector_type(8)));
typedef float f32x4 __attribute__((ext_vector_type(4)));
typedef float f32x2 __attribute__((ext_vector_type(2)));
typedef float f32x16 __attribute__((ext_vector_type(16)));
typedef unsigned u32x4 __attribute__((ext_vector_type(4)));
typedef unsigned u32x2 __attribute__((ext_vector_type(2)));
typedef __bf16 bf16x2_t __attribute__((ext_vector_type(2)));

#ifndef MK_MULTI
#define MK_MULTI 0
#endif

constexpr int T_TOK = 32768, DM = 1024, SEQ = 8192, DFF = 4096;
constexpr int NSA_N = 2608, NSA_NPAD = 2816;
constexpr size_t MiB = 1u << 20;
constexpr size_t WS_KMAX = 4096 + 128;
constexpr size_t WS_BAR = 4096;
constexpr size_t WS_C1 = 0;
constexpr size_t W_RGIN = 2 * MiB;
constexpr size_t W_RGGATE = W_RGIN + 8 * MiB;
constexpr size_t W_RGOUT = W_RGGATE + 2 * MiB;
constexpr size_t NSAIN_BYTES = (size_t)NSA_NPAD * 1024 * 2;
constexpr size_t W_NSAIN = W_RGOUT + 4 * MiB;
constexpr size_t W_W1 = W_NSAIN + 2 * NSAIN_BYTES;
constexpr size_t W_NSAOUT = W_W1 + 4 * MiB;
constexpr size_t W_UP = W_NSAOUT + 4 * MiB;
constexpr size_t W_DN = W_UP + 32 * MiB;
constexpr size_t W_END = W_DN + 32 * MiB;
static_assert(W_END <= 100 * MiB, "weights");
constexpr size_t WS_HB = 100 * MiB;
constexpr size_t WS_XPRE = 164 * MiB;
constexpr size_t WS_BIG = 228 * MiB;
constexpr size_t WS_A = WS_BIG, WS_XB = WS_BIG + 64 * MiB, WS_U = WS_BIG + 128 * MiB, WS_Y = WS_BIG + 192 * MiB;
constexpr size_t WS_Q = WS_BIG, WS_KV = WS_BIG + 64 * MiB, WS_GATE = WS_BIG + 160 * MiB, WS_MID = WS_BIG + 168 * MiB, WS_KC = WS_BIG + 170 * MiB, WS_VC = WS_BIG + 171 * MiB;
constexpr size_t WS_SUMP = 484 * MiB, WS_SUMH = 486 * MiB, WS_CARRY = 488 * MiB, WS_PART = 490 * MiB, WS_END = 492 * MiB;
constexpr size_t KV_ELEMS = (size_t)T_TOK * 256;

constexpr int LDS_BYTES = 147456;
constexpr int NTHREADS = 512;

__device__ __forceinline__ unsigned pk_bf16(float lo, float hi) { f32x2 v = {lo, hi}; bf16x2_t b = __builtin_convertvector(v, bf16x2_t); return __builtin_bit_cast(unsigned, b); }
__device__ __forceinline__ float bf_lo(unsigned w) { return __builtin_bit_cast(float, w << 16); }
__device__ __forceinline__ float bf_hi(unsigned w) { return __builtin_bit_cast(float, w & 0xffff0000u); }
__device__ __forceinline__ float bf2f(bf16_t h) { return __builtin_bit_cast(float, (unsigned)h << 16); }
__device__ __forceinline__ float fast_exp2(float x) { return __builtin_amdgcn_exp2f(x); }
__device__ __forceinline__ float fast_rcp(float x) { return __builtin_amdgcn_rcpf(x); }
__device__ __forceinline__ float sigmoidf_(float z) { return fast_rcp(1.f + fast_exp2(-1.4426950408889634f * z)); }
__device__ __forceinline__ float gelu_tanh(float x) {
    const float z = x + 0.044715f * x * x * x;
    return x * fast_rcp(1.f + fast_exp2(-2.3022081983f * z));
}
__device__ __forceinline__ float my_log1p(float x) {
    return (x < 0.03f) ? x * (1.f - x * (0.5f - x * (0.33333334f - 0.25f * x))) : __builtin_amdgcn_logf(1.f + x) * 0.6931471806f;
}
__device__ __forceinline__ float my_expm1(float x) {
    const float p = x * (1.f + x * (0.5f + x * (0.16666667f + x * (0.041666668f + x * (0.0083333338f + x * 0.0013888889f)))));
    return (x > -0.25f) ? p : fast_exp2(1.4426950408889634f * x) - 1.f;
}
__device__ __forceinline__ int vslot(int k) { return (k & 19) | ((k & 4) << 1) | ((k & 8) >> 1); }
__device__ __forceinline__ float shx(float v, int o, int lane) { return __builtin_bit_cast(float, __builtin_amdgcn_ds_bpermute((lane ^ o) << 2, __builtin_bit_cast(int, v))); }
__device__ __forceinline__ float wave_sum(float v, int lane) {
#pragma unroll
    for (int o = 1; o < 64; o <<= 1) v += shx(v, o, lane);
    return v;
}

namespace pg8 {
constexpr int BM = 256, BK = 64, HALF = 128, HTB = HALF * BK * 2, NXCD = 8, WGM = 4;
__host__ __device__ __forceinline__ int lds_byte(int r, int c) { const int st = (r >> 4) * 2 + (c >> 5), rr = r & 15, cc = c & 31, ob = rr * 64 + cc * 2; return st * 1024 + (ob ^ (((ob >> 9) & 1) << 5)); }
__host__ __device__ __forceinline__ void stage_rc(int b, int& R, int& C) { const int st = b / 1024, sb = b % 1024, swz = sb ^ (((sb >> 9) & 1) << 5); R = (st >> 1) * 16 + swz / 64; C = (st & 1) * 32 + (swz % 64) / 2; }
__host__ __device__ __forceinline__ int perm32(int rho) { const int n = rho >> 4, i = rho & 15; return 8 * (i >> 2) + 4 * n + (i & 3); }

struct Unit { int pm, pn; };
struct Gemm { const bf16_t* A; const bf16_t* Bt; int lda, ldb, K, adiv, amul; };

struct StaticOrder {
    int nM, nN, nwg, G, c, alt;
    __device__ void init(int M, int N, int G_, int c_, int alt_ = 0) { nM = M / BM; nN = N / BM; nwg = nM * nN; G = G_; c = c_; alt = alt_; }
    __device__ bool next(int i, Unit& u) const {
        const long L = (long)i * G + c; if (L >= nwg) return false;
        int wgid = (int)L; { const int q = nwg / NXCD, r = nwg % NXCD, xcd = wgid % NXCD, off = wgid / NXCD; wgid = (xcd < r ? xcd * (q + 1) : r * (q + 1) + (xcd - r) * q) + off; }
        if (alt) {
            const int band = wgid >> 8, w = wgid & 255, rnd = w >> 5, inner = w & 31;
            u.pm = band * 16 + (rnd & 3) * 4 + (inner & 3); u.pn = (rnd >> 2) * 8 + (inner >> 2); return true; }
        const int nig = WGM * nN, gid = wgid / nig, fm = gid * WGM, gsz = (nM - fm) < WGM ? (nM - fm) : WGM;
        u.pm = fm + ((wgid % nig) % gsz); u.pn = (wgid % nig) / gsz; return true;
    }
};

template <class Epi>
__device__ __forceinline__ void gemm_phase(LAS unsigned char* lds, const int tid, const Gemm g, const StaticOrder& S, const Epi& E) {
    const int wid = __builtin_amdgcn_readfirstlane(tid >> 6), lane = tid & 63, wr = wid >> 2, wc = wid & 3, fr = lane & 15, fq = lane >> 4;
    const int K = g.K, nt = K / BK;
    unsigned voffA, voffB;
    { int R, C; stage_rc(tid * 16, R, C); const int Rb = (R & ~31) + perm32(R & 31);
      voffA = (unsigned)(R * g.lda + C) * 2u; voffB = (unsigned)(Rb * g.ldb + C) * 2u; }
    const size_t rstep_voffA = (size_t)64 * g.lda * 2, rstep_voffB = (size_t)64 * g.ldb * 2;
    const size_t kstep = (size_t)(BK * 2);
    const size_t hstepA = (size_t)HALF * g.lda * 2, hstepB = (size_t)HALF * g.ldb * 2;
    const unsigned ldsw = (unsigned)wid * 1024u;
    const int aoff = lds_byte(wr * 64 + fr, fq * 8), boff = lds_byte(wc * 32 + fr, fq * 8);
#define PG8_TA(u) ((const char*)g.A + ((size_t)(u).pm * 256 * g.lda + (size_t)((u).pn / g.adiv) * g.amul) * 2)
#define PG8_TB(u) ((const char*)g.Bt + (size_t)(u).pn * 256 * g.ldb * 2)
#define PG8_SA(b, h) (((b) * 2 + (h)) * HTB)
#define PG8_SB(b, h) ((4 + (b) * 2 + (h)) * HTB)
#define PG8_STAGE(bufoff, gbase, voff) do { _Pragma("unroll") for (int _i = 0; _i < 2; ++_i) \
        __builtin_amdgcn_global_load_lds((const unsigned*)((const char*)(gbase) + _i * rstep_##voff + (voff)), (LAS unsigned*)(lds + (bufoff) + ldsw + _i * 8192), 16, 0, 0); } while (0)
#define PG8_LDA(dst, b, h) do { _Pragma("unroll") for (int m = 0; m < 4; ++m) _Pragma("unroll") for (int k = 0; k < 2; ++k) dst[m][k] = *(const LAS bf16x8*)(lds + PG8_SA(b, h) + aoff + m * 2048 + k * 1024); } while (0)
#define PG8_LDB(dst, b, h) do { _Pragma("unroll") for (int n = 0; n < 2; ++n) _Pragma("unroll") for (int k = 0; k < 2; ++k) dst[n][k] = *(const LAS bf16x8*)(lds + PG8_SB(b, h) + boff + n * 2048 + k * 1024); } while (0)
#define PG8_MMA(ai, bj, At, Bt) do { __builtin_amdgcn_s_setprio(1); _Pragma("unroll") for (int m = 0; m < 4; ++m) _Pragma("unroll") for (int n = 0; n < 2; ++n) _Pragma("unroll") for (int k = 0; k < 2; ++k) \
        acc[ai][bj][m][n] = __builtin_amdgcn_mfma_f32_16x16x32_bf16(Bt[n][k], At[m][k], acc[ai][bj][m][n], 0, 0, 0); __builtin_amdgcn_s_setprio(0); } while (0)
#define PG8_WAIT_V(n) asm volatile("s_waitcnt vmcnt(" #n ")" ::: "memory")
#define PG8_WAIT_L(n) asm volatile("s_waitcnt lgkmcnt(" #n ")" ::: "memory")
#define PG8_BAR __builtin_amdgcn_s_barrier()
#define PG8_SCHED __builtin_amdgcn_sched_barrier(0)
    Unit cur, nxt; int ui = 0;
    if (!S.next(0, cur)) return;
    f32x4 acc[2][2][4][2];
#pragma unroll
    for (int a = 0; a < 2; ++a)
#pragma unroll
        for (int b = 0; b < 2; ++b)
#pragma unroll
            for (int m = 0; m < 4; ++m)
#pragma unroll
                for (int n = 0; n < 2; ++n) acc[a][b][m][n] = (f32x4){0.f, 0.f, 0.f, 0.f};
    bf16x8 At[4][2], B0[2][2], B1[2][2];
    const char* cA = PG8_TA(cur); const char* cB = PG8_TB(cur);
    PG8_STAGE(PG8_SB(0, 0), cB, voffB); PG8_STAGE(PG8_SB(0, 1), cB + hstepB, voffB); PG8_STAGE(PG8_SA(0, 0), cA, voffA); PG8_STAGE(PG8_SA(0, 1), cA + hstepA, voffA);
    if (wr == 1) PG8_BAR;
    PG8_WAIT_V(2); PG8_BAR;
    PG8_STAGE(PG8_SB(1, 0), cB + kstep, voffB); PG8_STAGE(PG8_SA(1, 0), cA + kstep, voffA); PG8_STAGE(PG8_SB(1, 1), cB + hstepB + kstep, voffB);
    PG8_WAIT_V(6); PG8_BAR;
    for (;;) {
        const bool has_next = S.next(ui + 1, nxt);
        const char* nA = has_next ? PG8_TA(nxt) : cA; const char* nB = has_next ? PG8_TB(nxt) : cB;
        for (int t = 0; t < nt; t += 2) {
            const bool last = (t == nt - 2);
            const char* a1 = cA + (size_t)(t + 1) * kstep;
            const char* a2 = last ? nA : cA + (size_t)(t + 2) * kstep; const char* b2 = last ? nB : cB + (size_t)(t + 2) * kstep;
            const char* a3 = a2 + kstep; const char* b3 = b2 + kstep;
            PG8_LDB(B0, 0, 0); PG8_LDB(B1, 0, 1); PG8_SCHED; PG8_LDA(At, 0, 0); PG8_STAGE(PG8_SA(1, 1), a1 + hstepA, voffA);
            PG8_WAIT_V(8); PG8_WAIT_L(0); PG8_BAR; PG8_MMA(0, 0, At, B0); PG8_MMA(0, 1, At, B1); PG8_BAR; PG8_SCHED;
            PG8_LDA(At, 0, 1); PG8_STAGE(PG8_SB(0, 0), b2, voffB); PG8_STAGE(PG8_SB(0, 1), b2 + hstepB, voffB); PG8_STAGE(PG8_SA(0, 0), a2, voffA);
            PG8_WAIT_V(8); PG8_WAIT_L(0); PG8_BAR; PG8_MMA(1, 0, At, B0); PG8_MMA(1, 1, At, B1); PG8_BAR; PG8_SCHED;
            PG8_LDB(B0, 1, 0); PG8_LDB(B1, 1, 1); PG8_SCHED; PG8_LDA(At, 1, 0); PG8_STAGE(PG8_SA(0, 1), a2 + hstepA, voffA);
            PG8_WAIT_V(8); PG8_WAIT_L(0); PG8_BAR; PG8_MMA(0, 0, At, B0); PG8_MMA(0, 1, At, B1); PG8_BAR; PG8_SCHED;
            PG8_LDA(At, 1, 1); PG8_STAGE(PG8_SB(1, 0), b3, voffB); PG8_STAGE(PG8_SB(1, 1), b3 + hstepB, voffB); PG8_STAGE(PG8_SA(1, 0), a3, voffA);
            PG8_WAIT_V(8); PG8_WAIT_L(0); PG8_BAR; PG8_MMA(1, 0, At, B0); PG8_MMA(1, 1, At, B1); PG8_BAR; PG8_SCHED;
        }
        if (wr == 0) PG8_BAR;
        E(acc, cur, wr, wc, fr, fq);
        if (!has_next) break;
#pragma unroll
        for (int a = 0; a < 2; ++a)
#pragma unroll
            for (int b = 0; b < 2; ++b)
#pragma unroll
                for (int m = 0; m < 4; ++m)
#pragma unroll
                    for (int n = 0; n < 2; ++n) acc[a][b][m][n] = (f32x4){0.f, 0.f, 0.f, 0.f};
        cur = nxt; cA = nA; cB = nB; ++ui;
        if (wr == 1) PG8_BAR;
    }
    PG8_WAIT_V(0);
    PG8_BAR;
#undef PG8_TA
#undef PG8_TB
#undef PG8_SA
#undef PG8_SB
#undef PG8_STAGE
#undef PG8_LDA
#undef PG8_LDB
#undef PG8_MMA
#undef PG8_WAIT_V
#undef PG8_WAIT_L
#undef PG8_BAR
#undef PG8_SCHED
}

typedef const f32x4 (&AccRef)[2][2][4][2];
template <int N> __device__ __forceinline__ float dpp_shr(float v, float ident) {
    return __builtin_bit_cast(float, __builtin_amdgcn_update_dpp(__builtin_bit_cast(int, ident), __builtin_bit_cast(int, v), 0x110 + N, 0xf, 0xf, false));
}
__device__ __forceinline__ void lru_row_scan(float& P, float& H) {
    { const float Pl = dpp_shr<1>(P, 1.f), Hl = dpp_shr<1>(H, 0.f); H = __builtin_fmaf(P, Hl, H); P *= Pl; }
    { const float Pl = dpp_shr<2>(P, 1.f), Hl = dpp_shr<2>(H, 0.f); H = __builtin_fmaf(P, Hl, H); P *= Pl; }
    { const float Pl = dpp_shr<4>(P, 1.f), Hl = dpp_shr<4>(H, 0.f); H = __builtin_fmaf(P, Hl, H); P *= Pl; }
    { const float Pl = dpp_shr<8>(P, 1.f), Hl = dpp_shr<8>(H, 0.f); H = __builtin_fmaf(P, Hl, H); P *= Pl; }
}
__device__ __forceinline__ float row_rs(const float* PART, int row) {
    const f32x4* p = (const f32x4*)(PART + (size_t)row * 16); const f32x4 a = p[0], b = p[1], c = p[2], d = p[3];
    const float s = (((a.x + a.y) + (a.z + a.w)) + ((b.x + b.y) + (b.z + b.w))) + (((c.x + c.y) + (c.z + c.w)) + ((d.x + d.y) + (d.z + d.w)));
    return __builtin_amdgcn_rsqf(s * (1.f / 1024.f) + 1e-6f);
}

struct EpiRgIn { unsigned char* ws;
    __device__ __forceinline__ void operator()(AccRef acc, const Unit& u, int wr, int wc, int fr, int fq) const {
        const float* const PART = (const float*)(ws + WS_PART);
        const bool isY = u.pn < 4; bf16_t* base = isY ? (bf16_t*)(ws + WS_Y) : (bf16_t*)(ws + WS_XPRE); const int colt = (u.pn & 3) * 256 + wc * 32 + 8 * fq;
#pragma unroll
        for (int ai = 0; ai < 2; ++ai)
#pragma unroll
            for (int m = 0; m < 4; ++m) { const int row = u.pm * 256 + ai * 128 + wr * 64 + m * 16 + fr; const float rs = row_rs(PART, row);
#pragma unroll
                for (int bj = 0; bj < 2; ++bj) { f32x4 v0 = acc[ai][bj][m][0] * rs, v1 = acc[ai][bj][m][1] * rs;
                    if (isY) {
#pragma unroll
                        for (int e = 0; e < 4; ++e) { v0[e] = gelu_tanh(v0[e]); v1[e] = gelu_tanh(v1[e]); } }
                    u32x4 w; w.x = pk_bf16(v0[0], v0[1]); w.y = pk_bf16(v0[2], v0[3]); w.z = pk_bf16(v1[0], v1[1]); w.w = pk_bf16(v1[2], v1[3]);
                    *(u32x4*)(base + (size_t)row * 1024 + colt + bj * 128) = w; } }
    }
};
struct EpiGates { unsigned char* ws; const float* b_a; const float* b_x; const float* lam;
    __device__ __forceinline__ void operator()(AccRef acc, const Unit& u, int wr, int wc, int fr_, int fq_) const {
        const int le = __builtin_amdgcn_mbcnt_hi(~0u, __builtin_amdgcn_mbcnt_lo(~0u, 0u)), fr = le & 15, fq = le >> 4; (void)fr_; (void)fq_;
        const bf16_t* const XB = (const bf16_t*)(ws + WS_XB); bf16_t* const Aout = (bf16_t*)(ws + WS_A); bf16_t* const Uout = (bf16_t*)(ws + WS_U);
        const int ch0 = u.pn * 128 + wc * 32 + 8 * fq;
        float sp[8], ba[8], bx[8];
#pragma unroll
        for (int e = 0; e < 8; ++e) { sp[e] = 8.f * my_log1p(fast_exp2(-1.4426950408889634f * lam[ch0 + e])); ba[e] = b_a[ch0 + e]; bx[e] = b_x[ch0 + e]; }
#pragma unroll
        for (int ai = 0; ai < 2; ++ai) {
            float Pr[8], Hr[8];
#pragma unroll
            for (int e = 0; e < 8; ++e) { Pr[e] = 1.f; Hr[e] = 0.f; }
#pragma unroll
            for (int m = 0; m < 4; ++m) { const int row = u.pm * 256 + ai * 128 + wr * 64 + m * 16 + fr;
                const u32x4 xw = *(const u32x4*)(XB + (size_t)row * 1024 + ch0);
                float xb[8] = {bf_lo(xw.x), bf_hi(xw.x), bf_lo(xw.y), bf_hi(xw.y), bf_lo(xw.z), bf_hi(xw.z), bf_lo(xw.w), bf_hi(xw.w)};
                float av[8], uv[8];
#pragma unroll
                for (int e = 0; e < 8; ++e) { const float ra = acc[ai][0][m][e >> 2][e & 3] + ba[e], rx = acc[ai][1][m][e >> 2][e & 3] + bx[e];
                    const float r = sigmoidf_(ra), ig = sigmoidf_(rx);
                    const float la = -sp[e] * r; av[e] = -my_expm1(la);     uv[e] = __builtin_amdgcn_sqrtf(fmaxf(-my_expm1(2.f * la), 0.f)) * ig * xb[e]; }
                u32x4 wa; wa.x = pk_bf16(av[0], av[1]); wa.y = pk_bf16(av[2], av[3]); wa.z = pk_bf16(av[4], av[5]); wa.w = pk_bf16(av[6], av[7]);
                *(u32x4*)(Aout + (size_t)row * 1024 + ch0) = wa;
                u32x4 w; w.x = pk_bf16(uv[0], uv[1]); w.y = pk_bf16(uv[2], uv[3]); w.z = pk_bf16(uv[4], uv[5]); w.w = pk_bf16(uv[6], uv[7]);
                *(u32x4*)(Uout + (size_t)row * 1024 + ch0) = w;
                const unsigned waw[4] = {wa.x, wa.y, wa.z, wa.w}, wuw[4] = {w.x, w.y, w.z, w.w};
#pragma unroll
                for (int e = 0; e < 8; ++e) { float P = 1.f - ((e & 1) ? bf_hi(waw[e >> 1]) : bf_lo(waw[e >> 1])), H = (e & 1) ? bf_hi(wuw[e >> 1]) : bf_lo(wuw[e >> 1]);
                    lru_row_scan(P, H);
                    Hr[e] = __builtin_fmaf(Hr[e], P, H); Pr[e] *= P; } }
            if (fr == 15) { const size_t so = (size_t)(u.pm * 4 + ai * 2 + wr) * 1024 + ch0; float* sp_ = (float*)(ws + WS_SUMP) + so; float* sh_ = (float*)(ws + WS_SUMH) + so;
                *(f32x4*)sp_ = (f32x4){Pr[0], Pr[1], Pr[2], Pr[3]}; *(f32x4*)(sp_ + 4) = (f32x4){Pr[4], Pr[5], Pr[6], Pr[7]};
                *(f32x4*)sh_ = (f32x4){Hr[0], Hr[1], Hr[2], Hr[3]}; *(f32x4*)(sh_ + 4) = (f32x4){Hr[4], Hr[5], Hr[6], Hr[7]}; }
        }
    }
};
struct EpiResid { unsigned char* ws;
    __device__ __forceinline__ void operator()(AccRef acc, const Unit& u, int wr, int wc, int fr_, int fq_) const {
        bf16_t* const X16 = (bf16_t*)(ws + WS_HB); float* const PART = (float*)(ws + WS_PART);
        const int lane = __builtin_amdgcn_mbcnt_hi(~0u, __builtin_amdgcn_mbcnt_lo(~0u, 0u)), fr = lane & 15, fq = lane >> 4; (void)fr_; (void)fq_;
#pragma unroll
        for (int ai = 0; ai < 2; ++ai)
#pragma unroll
            for (int m = 0; m < 4; ++m) { const int row = u.pm * 256 + ai * 128 + wr * 64 + m * 16 + fr; float ss = 0.f;
#pragma unroll
                for (int bj = 0; bj < 2; ++bj) { bf16_t* xp = X16 + (size_t)row * 1024 + u.pn * 256 + bj * 128 + wc * 32 + 8 * fq;
                    const u32x4 xw = *(const u32x4*)xp; const f32x4 a0 = acc[ai][bj][m][0], a1 = acc[ai][bj][m][1];
                    u32x4 w; w.x = pk_bf16(bf_lo(xw.x) + a0[0], bf_hi(xw.x) + a0[1]); w.y = pk_bf16(bf_lo(xw.y) + a0[2], bf_hi(xw.y) + a0[3]);
                    w.z = pk_bf16(bf_lo(xw.z) + a1[0], bf_hi(xw.z) + a1[1]); w.w = pk_bf16(bf_lo(xw.w) + a1[2], bf_hi(xw.w) + a1[3]);
                    *(u32x4*)xp = w;
                    ss += (bf_lo(w.x) * bf_lo(w.x) + bf_hi(w.x) * bf_hi(w.x)) + (bf_lo(w.y) * bf_lo(w.y) + bf_hi(w.y) * bf_hi(w.y));
                    ss += (bf_lo(w.z) * bf_lo(w.z) + bf_hi(w.z) * bf_hi(w.z)) + (bf_lo(w.w) * bf_lo(w.w) + bf_hi(w.w) * bf_hi(w.w)); }
                ss += shx(ss, 16, lane); ss += shx(ss, 32, lane);
                if (fq == 0) PART[(size_t)row * 16 + u.pn * 4 + wc] = ss; }
    }
};
struct EpiRelu2 { unsigned char* ws;
    __device__ __forceinline__ void operator()(AccRef acc, const Unit& u, int wr, int wc, int fr, int fq) const {
        bf16_t* const H = (bf16_t*)(ws + WS_BIG); const float* const PART = (const float*)(ws + WS_PART);
#pragma unroll
        for (int ai = 0; ai < 2; ++ai)
#pragma unroll
            for (int m = 0; m < 4; ++m) { const int row = u.pm * 256 + ai * 128 + wr * 64 + m * 16 + fr; const float rs = row_rs(PART, row);
#pragma unroll
                for (int bj = 0; bj < 2; ++bj) { f32x4 v0 = acc[ai][bj][m][0] * rs, v1 = acc[ai][bj][m][1] * rs;
#pragma unroll
                    for (int e = 0; e < 4; ++e) { const float a = fmaxf(v0[e], 0.f), b = fmaxf(v1[e], 0.f); v0[e] = a * a; v1[e] = b * b; }
                    u32x4 w; w.x = pk_bf16(v0[0], v0[1]); w.y = pk_bf16(v0[2], v0[3]); w.z = pk_bf16(v1[0], v1[1]); w.w = pk_bf16(v1[2], v1[3]);
                    __builtin_nontemporal_store(w, (u32x4*)(H + (size_t)row * 4096 + u.pn * 256 + bj * 128 + wc * 32 + 8 * fq)); } }
    }
};
struct EpiNsaIn { unsigned char* ws; const float* b_gate;
    __device__ __forceinline__ void operator()(AccRef acc, const Unit& u, int wr, int wc, int fr, int fq) const {
        bf16_t* const Q = (bf16_t*)(ws + WS_Q); bf16_t* const KV = (bf16_t*)(ws + WS_KV); float* const GATES = (float*)(ws + WS_GATE); const float* const PART = (const float*)(ws + WS_PART);
        constexpr float qscale = 0.125f * 1.4426950408889634f;
        const int pn = u.pn;
#pragma unroll
        for (int ai = 0; ai < 2; ++ai)
#pragma unroll
            for (int m = 0; m < 4; ++m) { const int row = u.pm * 256 + ai * 128 + wr * 64 + m * 16 + fr; const float rs = row_rs(PART, row);
#pragma unroll
                for (int bj = 0; bj < 2; ++bj) { const int colt = bj * 128 + wc * 32 + 8 * fq; f32x4 v0 = acc[ai][bj][m][0] * rs, v1 = acc[ai][bj][m][1] * rs;
                    if (pn < 4) { v0 = v0 * qscale; v1 = v1 * qscale;
                        u32x4 w; w.x = pk_bf16(v0[0], v0[1]); w.y = pk_bf16(v0[2], v0[3]); w.z = pk_bf16(v1[0], v1[1]); w.w = pk_bf16(v1[2], v1[3]);
                        *(u32x4*)(Q + (size_t)row * 1024 + pn * 256 + colt) = w;
                    } else if (pn < 10) { const int kvi = pn - 4, g = colt >> 6, d0 = colt & 63, b = row >> 13, s = row & 8191, bg = b * 4 + g;
                        bf16_t* base = KV + (size_t)kvi * KV_ELEMS;
                        u32x4 w; w.x = pk_bf16(v0[0], v0[1]); w.y = pk_bf16(v0[2], v0[3]); w.z = pk_bf16(v1[0], v1[1]); w.w = pk_bf16(v1[2], v1[3]);
                        if (kvi == 3 || kvi == 5) {
                            bf16_t* p = base + ((size_t)(bg * 256 + (s >> 5)) * 2048 + d0 * 32 + vslot(s & 31));
                            p[0] = (bf16_t)(w.x & 0xffff); p[32] = (bf16_t)(w.x >> 16); p[64] = (bf16_t)(w.y & 0xffff); p[96] = (bf16_t)(w.y >> 16);
                            p[128] = (bf16_t)(w.z & 0xffff); p[160] = (bf16_t)(w.z >> 16); p[192] = (bf16_t)(w.w & 0xffff); p[224] = (bf16_t)(w.w >> 16);
                        } else *(u32x4*)(base + ((size_t)(bg * 8192 + s) * 64 + d0)) = w;
                    } else if (colt < 48) { float* gp = GATES + (size_t)row * 48 + colt;
                        *(f32x4*)gp = (f32x4){sigmoidf_(v0[0] + b_gate[colt]), sigmoidf_(v0[1] + b_gate[colt + 1]), sigmoidf_(v0[2] + b_gate[colt + 2]), sigmoidf_(v0[3] + b_gate[colt + 3])};
                        *(f32x4*)(gp + 4) = (f32x4){sigmoidf_(v1[0] + b_gate[colt + 4]), sigmoidf_(v1[1] + b_gate[colt + 5]), sigmoidf_(v1[2] + b_gate[colt + 6]), sigmoidf_(v1[3] + b_gate[colt + 7])};
                    } } }
    }
};
struct EpiCmp { bf16_t* MID; const float* c1;
    __device__ __forceinline__ void operator()(AccRef acc, const Unit& u, int wr, int wc, int fr, int fq) const {
        const int colt = wc * 32 + 8 * fq;
        if (colt >= 64) return;
#pragma unroll
        for (int ai = 0; ai < 2; ++ai)
#pragma unroll
            for (int m = 0; m < 4; ++m) { const int row = u.pm * 256 + ai * 128 + wr * 64 + m * 16 + fr;
                f32x4 v0 = acc[ai][0][m][0], v1 = acc[ai][0][m][1];
#pragma unroll
                for (int e = 0; e < 4; ++e) { v0[e] = gelu_tanh(v0[e] + c1[colt + e]); v1[e] = gelu_tanh(v1[e] + c1[colt + 4 + e]); }
                u32x4 w; w.x = pk_bf16(v0[0], v0[1]); w.y = pk_bf16(v0[2], v0[3]); w.z = pk_bf16(v1[0], v1[1]); w.w = pk_bf16(v1[2], v1[3]);
                *(u32x4*)(MID + (size_t)row * 64 + colt) = w; }
    }
};
}

namespace att {
constexpr int KROW = 176, VROW = 80;
constexpr int KT_BYTES = 32 * KROW, VT_BYTES = 64 * VROW;
constexpr int OFF_K = 0, OFF_V = 4 * KT_BYTES, OFF_IMP = OFF_V + 4 * VT_BYTES, IMP_STRIDE = 132, OFF_SEL = OFF_IMP + 64 * IMP_STRIDE * 4, OFF_OT = OFF_SEL + 1024, ATT_LDS = OFF_OT + 32 * 512 * 4;
static_assert(ATT_LDS <= LDS_BYTES, "attention LDS");
enum { CMP1 = 0, CMP2 = 1, SEL = 2, WIN = 3 };
#define MFMA32(a, b, c) __builtin_amdgcn_mfma_f32_32x32x16_bf16((a), (b), (c), 0, 0, 0)
__device__ __forceinline__ unsigned bf_int(int n) { return __builtin_bit_cast(unsigned, (float)n) >> 16; }

template <int MODE>
__device__ __forceinline__ void tile_compute(LAS unsigned char* lds, const LAS unsigned char* kbuf, const LAS unsigned char* vbuf, const int kt, const bool need_mask, const bool sel,
                                             const bf16x8 (&qf)[4], const bf16x8 qaug, const int t, const int ql, const int hg, const int half, const int lane,
                                             float& m_run, float& l_run, f32x16& O0, f32x16& O1, const float inv_l, float& carry) {
    f32x16 s;
#pragma unroll
    for (int r = 0; r < 16; ++r) s[r] = 0.f;
    const LAS unsigned char* kb = kbuf + (lane & 31) * KROW;
#pragma unroll
    for (int ks = 0; ks < 4; ++ks) { const bf16x8 kf = *(const LAS bf16x8*)(kb + half * 16 + ks * 32); s = MFMA32(kf, qf[ks], s); }
    { u32x4 kw = *(const LAS u32x4*)(kb + 128); if (half) kw = (u32x4){0u, 0u, 0u, 0u}; s = MFMA32(__builtin_bit_cast(bf16x8, kw), qaug, s); }
    if (need_mask) {
        constexpr float DSTEP = (MODE == CMP1 || MODE == CMP2) ? 16.f : 1.f;
        const float dl = (MODE == CMP1 || MODE == CMP2) ? (float)(t - 31 - 512 * kt - 64 * half) : (float)(t - 32 * kt - 4 * half);
#pragma unroll
        for (int r = 0; r < 16; ++r) { const float d = dl - DSTEP * (float)((r & 3) + 8 * (r >> 2));
            const bool ok = (MODE == WIN) ? (d >= 0.f && d < 512.f) : (d >= 0.f);
            s[r] = ok ? s[r] : -1e30f; }
    }
    float p[16];
    if (MODE == CMP2) {
#pragma unroll
        for (int r = 0; r < 16; ++r) p[r] = fast_exp2(s[r] - m_run) * inv_l;
    } else {
        float mx = fmaxf(fmaxf(fmaxf(s[0], s[1]), fmaxf(s[2], s[3])), fmaxf(fmaxf(s[4], s[5]), fmaxf(s[6], s[7])));
        mx = fmaxf(mx, fmaxf(fmaxf(fmaxf(s[8], s[9]), fmaxf(s[10], s[11])), fmaxf(fmaxf(s[12], s[13]), fmaxf(s[14], s[15]))));
        if (MODE == SEL) mx = sel ? mx : -1e30f;
        mx = fmaxf(mx, shx(mx, 32, lane));
        if (__ballot(mx > m_run + 8.f) != 0ull) {
            const float m_new = fmaxf(m_run, mx), alpha = fast_exp2(m_run - m_new);
            l_run *= alpha; m_run = m_new;
            if (MODE != CMP1) { O0 = O0 * alpha; O1 = O1 * alpha; }
        }
        const float msub = (MODE == SEL && !sel) ? 1e30f : m_run;
        f32x2 ls2 = {0.f, 0.f};
#pragma unroll
        for (int r = 0; r < 16; r += 2) { const f32x2 sv = {s[r], s[r + 1]}; const f32x2 dv = sv - msub;
            f32x2 pv; pv.x = fast_exp2(dv.x); pv.y = fast_exp2(dv.y); ls2 = ls2 + pv; p[r] = pv.x; p[r + 1] = pv.y; }
        l_run += ls2.x + ls2.y;
    }
    if (MODE != CMP1) {
        u32x4 pa, pb;
        pa.x = pk_bf16(p[0], p[1]); pa.y = pk_bf16(p[2], p[3]); pa.z = pk_bf16(p[4], p[5]); pa.w = pk_bf16(p[6], p[7]);
        pb.x = pk_bf16(p[8], p[9]); pb.y = pk_bf16(p[10], p[11]); pb.z = pk_bf16(p[12], p[13]); pb.w = pk_bf16(p[14], p[15]);
        const bf16x8 P0 = __builtin_bit_cast(bf16x8, pa), P1 = __builtin_bit_cast(bf16x8, pb);
        const LAS unsigned char* vb = vbuf + (lane & 31) * VROW + half * 16;
        const bf16x8 v00 = *(const LAS bf16x8*)(vb), v01 = *(const LAS bf16x8*)(vb + 32);
        const bf16x8 v10 = *(const LAS bf16x8*)(vb + 32 * VROW), v11 = *(const LAS bf16x8*)(vb + 32 * VROW + 32);
        O0 = MFMA32(v00, P0, O0); O0 = MFMA32(v01, P1, O0);
        O1 = MFMA32(v10, P0, O1); O1 = MFMA32(v11, P1, O1);
    }
    if (MODE == CMP2) {
        float mn[4], tl[4];
#pragma unroll
        for (int g = 0; g < 4; ++g) { mn[g] = 2.f * (p[4 * g] + p[4 * g + 1] + p[4 * g + 2]) + p[4 * g + 3]; tl[g] = p[4 * g + 3]; }
#pragma unroll
        for (int g = 0; g < 4; ++g) { mn[g] += shx(mn[g], 8, lane); tl[g] += shx(tl[g], 8, lane); }
#pragma unroll
        for (int g = 0; g < 4; ++g) { mn[g] += shx(mn[g], 16, lane); tl[g] += shx(tl[g], 16, lane); }
        float xg[4];
        xg[0] = shx(half ? carry : tl[0], 32, lane);
        xg[1] = shx(half ? tl[0] : tl[1], 32, lane);
        xg[2] = shx(half ? tl[1] : tl[2], 32, lane);
        xg[3] = shx(half ? tl[2] : tl[3], 32, lane);
        carry = tl[3];
        if (hg == 0) { LAS unsigned* kp = (LAS unsigned*)(lds + OFF_IMP) + ql * IMP_STRIDE;
#pragma unroll
            for (int g = 0; g < 4; ++g) { const int mblk = 8 * kt + 2 * g + half; const float iv = mn[g] + xg[g];
                if (mblk < 128) kp[mblk] = (__builtin_bit_cast(unsigned, iv) & ~127u) | (unsigned)(127 - mblk); } }
    }
}

template <int MODE>
__device__ __forceinline__ void attn_tiles(LAS unsigned char* lds, const int npairs, const bf16_t* Kbase, const bf16_t* Vbase, const int c,
                                           const bf16x8 (&qf)[4], const bf16x8 qaug, const int t, const int ql, const int hg, const int half, const int lane, const int tid,
                                           float& m_run, float& l_run, f32x16& O0, f32x16& O1, const float inv_l) {
    const bool isV = tid >= 256; const int ci = tid & 255;
    const bool stager = (MODE == CMP1) ? !isV : true;
    const bool augw = isV && ci < 64;
    const unsigned ldst = isV ? (unsigned)(OFF_V + (ci >> 2) * VROW + (ci & 3) * 16) : (unsigned)(OFF_K + (ci >> 3) * KROW + (ci & 7) * 16);
    const unsigned tstep = isV ? VT_BYTES : KT_BYTES;
    const unsigned laug = (unsigned)(OFF_K + (ci >> 5) * KT_BYTES + (ci & 31) * KROW + 128);
    const bf16_t* gsrc = (isV ? Vbase : Kbase) + ci * 8;
    float carry = 0.f;
#define BLK_OF(ip) ((MODE == CMP1 || MODE == CMP2) ? (ip) : ((ip) == 0 ? c : c - (ip)))
#define AUG_WORD(blk) ({ const int key_ = 64 * (blk) + ci; const int pos_ = (MODE == CMP1 || MODE == CMP2) ? 16 * key_ + 31 : key_; bf_int(pos_ >> 7) | (bf_int(pos_ & 127) << 16); })
    u32x4 stg0 = {0u, 0u, 0u, 0u}, stg1 = {0u, 0u, 0u, 0u};
    if (stager) { const bf16_t* g0 = gsrc + (size_t)BLK_OF(0) * 4096; stg0 = *(const u32x4*)g0; stg1 = *(const u32x4*)(g0 + 2048); }
    __syncthreads();
    if (stager) { *(LAS u32x4*)(lds + ldst) = stg0; *(LAS u32x4*)(lds + ldst + tstep) = stg1; }
    if (augw) { const unsigned w = AUG_WORD(BLK_OF(0)); *(LAS u32x4*)(lds + laug) = (u32x4){w, w, 0u, 0u}; }
    __syncthreads();
    for (int ip = 0; ip < npairs; ++ip) {
        const int buf = ip & 1, blk = BLK_OF(ip);
        if (ip + 1 < npairs && stager) { const bf16_t* g0 = gsrc + (size_t)BLK_OF(ip + 1) * 4096; stg0 = *(const u32x4*)g0; stg1 = *(const u32x4*)(g0 + 2048); }
        bool active = true, sel = true;
        if (MODE == SEL) {
            const unsigned w = ((const LAS unsigned short*)(lds + OFF_SEL))[ql * 8 + (blk >> 4)];
            sel = (w >> (blk & 15)) & 1u;
            active = __ballot(sel) != 0ull;
        }
        if (active) {
            bool need_mask;
            if (MODE == SEL) need_mask = ip == 0; else if (MODE == WIN) need_mask = (ip == 0) || (ip == 8); else need_mask = true;
#pragma unroll
            for (int sub = 0; sub < 2; ++sub)
                tile_compute<MODE>(lds, lds + OFF_K + (buf * 2 + sub) * KT_BYTES, lds + OFF_V + (buf * 2 + sub) * VT_BYTES, 2 * blk + sub, need_mask, sel,
                                   qf, qaug, t, ql, hg, half, lane, m_run, l_run, O0, O1, inv_l, carry);
        }
        if (ip + 1 < npairs) {
            if (stager) { *(LAS u32x4*)(lds + ldst + (buf ^ 1) * 2 * tstep) = stg0; *(LAS u32x4*)(lds + ldst + (buf ^ 1) * 2 * tstep + tstep) = stg1; }
            if (augw) { const unsigned w = AUG_WORD(BLK_OF(ip + 1)); *(LAS u32x4*)(lds + laug + (buf ^ 1) * 2 * KT_BYTES) = (u32x4){w, w, 0u, 0u}; }
        }
        __syncthreads();
    }
#undef BLK_OF
#undef AUG_WORD
}

__device__ __forceinline__ void attn_unit(LAS unsigned char* lds, const int bg, const int c, const bf16_t* Q, const bf16_t* KV, const bf16_t* KC, const bf16_t* VC,
                                          const float* GATES, bf16_t* O, const unsigned* KMAX, const int tid) {
    const int lane = tid & 63, wave = __builtin_amdgcn_readfirstlane(tid >> 6);
    const int col = lane & 31, half = lane >> 5, hg = col >> 3, ql = wave * 8 + (col & 7);
    const int b = bg >> 2, g = bg & 3, head = g * 4 + hg, t = c * 64 + ql;
    const size_t tok = (size_t)b * SEQ + t;
    const float sl2 = fast_exp2(-0.5f * (float)(head + 1)) * 1.4426950408889634f;
    bf16x8 qaug;
    { const float shf = bf_lo(pk_bf16(sl2, 0.f)), slo = sl2 - shf;
      u32x4 qa = {pk_bf16(shf * 128.f, shf), pk_bf16(slo * 128.f, slo), 0u, 0u}; if (half) qa = (u32x4){0u, 0u, 0u, 0u};
      qaug = __builtin_bit_cast(bf16x8, qa); }
    bf16x8 qf[4];
    { const bf16_t* qp = Q + tok * 1024 + head * 64 + half * 8;
#pragma unroll
      for (int ks = 0; ks < 4; ++ks) qf[ks] = *(const bf16x8*)(qp + ks * 16); }
    int blk_lo;
    { float qn2 = 0.f;
#pragma unroll
      for (int ks = 0; ks < 4; ++ks) { const u32x4 w = __builtin_bit_cast(u32x4, qf[ks]);
          qn2 += (bf_lo(w.x) * bf_lo(w.x) + bf_hi(w.x) * bf_hi(w.x)) + (bf_lo(w.y) * bf_lo(w.y) + bf_hi(w.y) * bf_hi(w.y));
          qn2 += (bf_lo(w.z) * bf_lo(w.z) + bf_hi(w.z) * bf_hi(w.z)) + (bf_lo(w.w) * bf_lo(w.w) + bf_hi(w.w) * bf_hi(w.w)); }
      qn2 += shx(qn2, 32, lane);
#pragma unroll
      for (int o = 1; o < 32; o <<= 1) qn2 = fmaxf(qn2, shx(qn2, o, lane));
      LAS float* qx = (LAS float*)(lds + OFF_SEL);
      __syncthreads();
      if (lane == 0) qx[wave] = qn2;
      __syncthreads();
      float qm2 = qx[0];
#pragma unroll
      for (int w8 = 1; w8 < 8; ++w8) qm2 = fmaxf(qm2, qx[w8]);
      const float km2 = __builtin_bit_cast(float, KMAX[bg]);
      const float sl2min = fast_exp2(-0.5f * (float)(4 * g + 4)) * 1.4426950408889634f;
      const float D = (64.f + 2.f * __builtin_amdgcn_sqrtf(qm2 * km2) * 1.01f) / sl2min;
      const float lim = (float)(64 * c) - D - 63.f;
      blk_lo = (lim >= 0.f) ? ((int)(lim * (1.f / 64.f)) + 1) : 0;
      blk_lo = __builtin_amdgcn_readfirstlane(blk_lo < c ? blk_lo : c);
      __syncthreads(); }
    const float* gp = GATES + tok * 48 + head * 3;
    const float g_c = gp[0], g_s = gp[1], g_w = gp[2];
    f32x16 O0, O1;
    LAS float* otp = (LAS float*)(lds + OFF_OT) + tid;
#pragma unroll
    for (int r = 0; r < 16; ++r) { O0[r] = 0.f; O1[r] = 0.f; }
    const bf16_t* Kc = KC + (size_t)bg * 512 * 64; const bf16_t* Vc = VC + (size_t)bg * 16 * 2048;
    const bf16_t* Ks = KV + 2 * KV_ELEMS + (size_t)bg * SEQ * 64; const bf16_t* Vs = KV + 3 * KV_ELEMS + (size_t)bg * SEQ * 64;
    const bf16_t* Kw = KV + 4 * KV_ELEMS + (size_t)bg * SEQ * 64; const bf16_t* Vw = KV + 5 * KV_ELEMS + (size_t)bg * SEQ * 64;

    const int ntc = (4 * c + 3 + 63) >> 6;
    float m_c = -1e30f, l_c = 0.f;
    attn_tiles<CMP1>(lds, ntc, Kc, Vc, c, qf, qaug, t, ql, hg, half, lane, tid, m_c, l_c, O0, O1, 0.f);
    l_c += shx(l_c, 32, lane);
    const float inv_c = (m_c > -1e29f) ? fast_rcp(fmaxf(l_c, 1e-30f)) : 0.f;
    attn_tiles<CMP2>(lds, ntc, Kc, Vc, c, qf, qaug, t, ql, hg, half, lane, tid, m_c, l_c, O0, O1, inv_c);
#pragma unroll
    for (int r = 0; r < 16; ++r) { otp[512 * r] = g_c * O0[r]; otp[512 * (16 + r)] = g_c * O1[r]; O0[r] = 0.f; O1[r] = 0.f; }
    { const int q = tid >> 3, part = tid & 7; unsigned bits = 0u;
      const LAS unsigned* keys = (const LAS unsigned*)(lds + OFF_IMP) + q * IMP_STRIDE;
      if (c < 16) {
#pragma unroll
          for (int e = 0; e < 16; ++e) if (part * 16 + e <= c) bits |= 1u << e;
      } else {
          unsigned ck[16];
#pragma unroll
          for (int e = 0; e < 16; ++e) { const int jb = part * 16 + e; ck[e] = (jb >= 1 && jb <= c - 2) ? keys[jb] : 0u; }
#pragma unroll 1
          for (int it = 0; it < 13; ++it) {
              unsigned m01 = ck[0] > ck[1] ? ck[0] : ck[1], m23 = ck[2] > ck[3] ? ck[2] : ck[3], m45 = ck[4] > ck[5] ? ck[4] : ck[5], m67 = ck[6] > ck[7] ? ck[6] : ck[7];
              unsigned m89 = ck[8] > ck[9] ? ck[8] : ck[9], mab = ck[10] > ck[11] ? ck[10] : ck[11], mcd = ck[12] > ck[13] ? ck[12] : ck[13], mef = ck[14] > ck[15] ? ck[14] : ck[15];
              m01 = m01 > m23 ? m01 : m23; m45 = m45 > m67 ? m45 : m67; m89 = m89 > mab ? m89 : mab; mcd = mcd > mef ? mcd : mef;
              m01 = m01 > m45 ? m01 : m45; m89 = m89 > mcd ? m89 : mcd;
              unsigned m = m01 > m89 ? m01 : m89;
              { const unsigned o = (unsigned)__builtin_amdgcn_update_dpp(0, (int)m, 0xB1, 0xf, 0xf, true); m = m > o ? m : o; }
              { const unsigned o = (unsigned)__builtin_amdgcn_update_dpp(0, (int)m, 0x4E, 0xf, 0xf, true); m = m > o ? m : o; }
              { const unsigned o = (unsigned)__builtin_amdgcn_update_dpp(0, (int)m, 0x141, 0xf, 0xf, true); m = m > o ? m : o; }
#pragma unroll
              for (int e = 0; e < 16; ++e) ck[e] = (ck[e] == m) ? 0u : ck[e];
          }
#pragma unroll
          for (int e = 0; e < 16; ++e) { const int jb = part * 16 + e;
              const bool forced = (jb == 0) || (jb == c) || (jb == c - 1);
              const bool cand = (jb >= 1) && (jb <= c - 2) && (ck[e] == 0u);
              if (forced || cand) bits |= 1u << e; }
      }
      ((LAS unsigned short*)(lds + OFF_SEL))[q * 8 + part] = (unsigned short)bits; }
    float m_s = -1e30f, l_s = 0.f;
    attn_tiles<SEL>(lds, c + 1 - blk_lo, Ks, Vs, c, qf, qaug, t, ql, hg, half, lane, tid, m_s, l_s, O0, O1, 0.f);
    l_s += shx(l_s, 32, lane);
    { const float f = g_s * fast_rcp(fmaxf(l_s, 1e-30f));
#pragma unroll
      for (int r = 0; r < 16; ++r) { otp[512 * r] += f * O0[r]; otp[512 * (16 + r)] += f * O1[r]; O0[r] = 0.f; O1[r] = 0.f; } }
    float m_w = -1e30f, l_w = 0.f;
    attn_tiles<WIN>(lds, 1 + (c < 8 ? c : 8), Kw, Vw, c, qf, qaug, t, ql, hg, half, lane, tid, m_w, l_w, O0, O1, 0.f);
    l_w += shx(l_w, 32, lane);
    f32x16 ot0, ot1;
    { const float f = g_w * fast_rcp(fmaxf(l_w, 1e-30f));
#pragma unroll
      for (int r = 0; r < 16; ++r) { ot0[r] = otp[512 * r] + f * O0[r]; ot1[r] = otp[512 * (16 + r)] + f * O1[r]; } }
    bf16_t* op = O + tok * 1024 + head * 64 + 4 * half;
#pragma unroll
    for (int gq = 0; gq < 4; ++gq) {
        u32x2 w0, w1; w0.x = pk_bf16(ot0[4 * gq], ot0[4 * gq + 1]); w0.y = pk_bf16(ot0[4 * gq + 2], ot0[4 * gq + 3]);
        w1.x = pk_bf16(ot1[4 * gq], ot1[4 * gq + 1]); w1.y = pk_bf16(ot1[4 * gq + 2], ot1[4 * gq + 3]);
        *(u32x2*)(op + 8 * gq) = w0; *(u32x2*)(op + 32 + 8 * gq) = w1; }
}
}

struct Params {
    const float* in[24]; float* out; unsigned char* ws; int ph_lo, ph_hi;
};

__device__ __forceinline__ void transpose_item(const float* src, int ld, int nvalid, int K, bf16_t* dst, int item, int nblk, LAS float* scr, int lane, const float* gk = nullptr) {
    const int kb = item / nblk, nb = item % nblk, k0 = 64 * kb, n0 = 32 * nb;
    const int n = n0 + (lane & 31);
#pragma unroll
    for (int i = 0; i < 32; ++i) { const int kk = 2 * i + (lane >> 5); scr[kk * 33 + (lane & 31)] = (n < nvalid) ? src[(size_t)(k0 + kk) * ld + n] * (gk ? gk[k0 + kk] : 1.f) : 0.f; }
    asm volatile("s_waitcnt lgkmcnt(0)" ::: "memory");
    const int cc = lane & 7;
#pragma unroll
    for (int j = 0; j < 4; ++j) { const int nn = (lane >> 3) + 8 * j; const LAS float* s = scr + (8 * cc) * 33 + nn;
        u32x4 o; o.x = pk_bf16(s[0], s[33]); o.y = pk_bf16(s[2 * 33], s[3 * 33]); o.z = pk_bf16(s[4 * 33], s[5 * 33]); o.w = pk_bf16(s[6 * 33], s[7 * 33]);
        *(u32x4*)(dst + (size_t)(n0 + nn) * K + k0 + 8 * cc) = o; }
    asm volatile("s_waitcnt lgkmcnt(0)" ::: "memory");
}

__device__ __forceinline__ void prep_phase(const __attribute__((address_space(4))) Params* Pq, LAS unsigned char* lds, const int tid, const int bx, const int G) {
    const int lane = tid & 63, wave = tid >> 6;
    LAS float* scr = (LAS float*)(lds + wave * 16384);
    const int gw = bx * 8 + wave, NGW = G * 8;
    unsigned char* ws = Pq->ws;
    constexpr int I_UP = 16 * 128, I_DN = 64 * 32, I_RGIN = 16 * 64, I_SQ = 16 * 32, I_GATE = 256, I_NSAIN = 16 * (NSA_NPAD / 32), I_W1 = 32 * 8;
    constexpr int NITEMS = 4 * I_UP + 4 * I_DN + 2 * I_RGIN + 2 * I_SQ + 2 * I_GATE + 2 * I_NSAIN + 2 * I_SQ + 4 * I_W1;
    for (int it = gw; it < NITEMS; it += NGW) {
        int r = it;
        if (r < 4 * I_UP) { const int L = r / I_UP; transpose_item(Pq->in[22] + (size_t)L * 1024 * 4096, 4096, 4096, 1024, (bf16_t*)(ws + W_UP) + (size_t)L * 4096 * 1024, r % I_UP, 128, scr, lane, Pq->in[2] + (size_t)L * 1024); continue; } r -= 4 * I_UP;
        if (r < 4 * I_DN) { const int L = r / I_DN; transpose_item(Pq->in[23] + (size_t)L * 4096 * 1024, 1024, 1024, 4096, (bf16_t*)(ws + W_DN) + (size_t)L * 1024 * 4096, r % I_DN, 32, scr, lane); continue; } r -= 4 * I_DN;
        if (r < 2 * I_RGIN) { const int j = r / I_RGIN; transpose_item(Pq->in[4] + (size_t)j * 1024 * 2048, 2048, 2048, 1024, (bf16_t*)(ws + W_RGIN) + (size_t)j * 2048 * 1024, r % I_RGIN, 64, scr, lane, Pq->in[1] + (size_t)(2 * j) * 1024); continue; } r -= 2 * I_RGIN;
        if (r < 2 * I_SQ) { const int j = r / I_SQ; transpose_item(Pq->in[12] + (size_t)j * 1024 * 1024, 1024, 1024, 1024, (bf16_t*)(ws + W_RGOUT) + (size_t)j * 1024 * 1024, r % I_SQ, 32, scr, lane); continue; } r -= 2 * I_SQ;
        if (r < 2 * I_GATE) { const int j = r / I_GATE, rr = r % I_GATE, sub = rr >> 4, pn = sub >> 1, bj = sub & 1, blk = pn >> 1;
            const float* src = (bj ? Pq->in[9] : Pq->in[7]) + ((size_t)(j * 4 + blk) * 256 * 256) + 128 * (pn & 1);
            transpose_item(src, 256, 128, 256, (bf16_t*)(ws + W_RGGATE) + (size_t)j * 2048 * 256 + (size_t)(256 * pn + 128 * bj) * 256, rr & 15, 4, scr, lane); continue; } r -= 2 * I_GATE;
        if (r < 2 * I_NSAIN) { const int j = r / I_NSAIN; transpose_item(Pq->in[13] + (size_t)j * 1024 * NSA_N, NSA_N, NSA_N, 1024, (bf16_t*)(ws + W_NSAIN + (size_t)j * NSAIN_BYTES), r % I_NSAIN, NSA_NPAD / 32, scr, lane, Pq->in[1] + (size_t)(2 * j + 1) * 1024); continue; } r -= 2 * I_NSAIN;
        if (r < 2 * I_SQ) { const int j = r / I_SQ; transpose_item(Pq->in[21] + (size_t)j * 1024 * 1024, 1024, 1024, 1024, (bf16_t*)(ws + W_NSAOUT) + (size_t)j * 1024 * 1024, r % I_SQ, 32, scr, lane); continue; } r -= 2 * I_SQ;
        { const int q = r / I_W1, j = q >> 1, kv = q & 1; transpose_item(Pq->in[kv ? 19 : 17] + (size_t)j * 2048 * 64, 64, 64, 2048, (bf16_t*)(ws + W_W1) + (size_t)q * 256 * 2048, r % I_W1, 8, scr, lane); }
    }
    { bf16_t* X16 = (bf16_t*)(ws + WS_HB); float* PART = (float*)(ws + WS_PART); const float* X = Pq->in[0];
      for (int row = gw; row < T_TOK; row += NGW) { const float* xr = X + (size_t)row * 1024 + 4 * lane; float ssq = 0.f;
#pragma unroll
          for (int q = 0; q < 4; ++q) { const f32x4 v = *(const f32x4*)(xr + 256 * q); u32x2 w; w.x = pk_bf16(v.x, v.y); w.y = pk_bf16(v.z, v.w);
              *(u32x2*)(X16 + (size_t)row * 1024 + 4 * lane + 256 * q) = w;
              ssq += (bf_lo(w.x) * bf_lo(w.x) + bf_hi(w.x) * bf_hi(w.x)) + (bf_lo(w.y) * bf_lo(w.y) + bf_hi(w.y) * bf_hi(w.y)); }
          ssq = wave_sum(ssq, lane);
          if (lane < 16) PART[(size_t)row * 16 + lane] = (lane == 0) ? ssq : 0.f; } }
    for (int o = gw; o < 256; o += NGW) { const int j = o >> 7, kv = (o >> 6) & 1, n = o & 63;
        const float* pe = Pq->in[kv ? 16 : 15] + (size_t)j * 2048; const float* w1 = Pq->in[kv ? 19 : 17] + (size_t)j * 2048 * 64;
        float s = 0.f;
        for (int f = lane; f < 2048; f += 64) s += pe[f] * w1[(size_t)f * 64 + n];
        s = wave_sum(s, lane);
        if (lane == 0) ((float*)(ws + WS_C1))[o] = s; }
}

__device__ __forceinline__ void final_norm_phase(const bf16_t* X16, const float* gam, float* OUT, const int tid, const int bx, const int G) {
    const int lane = tid & 63, gw = bx * 8 + (tid >> 6), NGW = G * 8;
    for (int row = gw; row < T_TOK; row += NGW) {
        const u32x4 w0 = *(const u32x4*)(X16 + (size_t)row * 1024 + 8 * lane), w1 = *(const u32x4*)(X16 + (size_t)row * 1024 + 512 + 8 * lane);
        float v[16] = {bf_lo(w0.x), bf_hi(w0.x), bf_lo(w0.y), bf_hi(w0.y), bf_lo(w0.z), bf_hi(w0.z), bf_lo(w0.w), bf_hi(w0.w),
                       bf_lo(w1.x), bf_hi(w1.x), bf_lo(w1.y), bf_hi(w1.y), bf_lo(w1.z), bf_hi(w1.z), bf_lo(w1.w), bf_hi(w1.w)};
        float s = 0.f;
#pragma unroll
        for (int e = 0; e < 16; ++e) s += v[e] * v[e];
        const float rs = __builtin_amdgcn_rsqf(wave_sum(s, lane) * (1.f / 1024.f) + 1e-6f);
#pragma unroll
        for (int h = 0; h < 2; ++h) { const float* gp = gam + 512 * h + 8 * lane; float* op = OUT + (size_t)row * 1024 + 512 * h + 8 * lane;
            const f32x4 g0 = *(const f32x4*)gp, g1 = *(const f32x4*)(gp + 4);
            *(f32x4*)op = (f32x4){v[8 * h] * rs * g0.x, v[8 * h + 1] * rs * g0.y, v[8 * h + 2] * rs * g0.z, v[8 * h + 3] * rs * g0.w};
            *(f32x4*)(op + 4) = (f32x4){v[8 * h + 4] * rs * g1.x, v[8 * h + 5] * rs * g1.y, v[8 * h + 6] * rs * g1.z, v[8 * h + 7] * rs * g1.w}; }
    }
}

__device__ __forceinline__ void conv_phase(const bf16_t* XPRE, const float* cw, const float* cb, bf16_t* XB, const int tid, const int bx, const int G) {
    const int gt = bx * NTHREADS + tid, NT = G * NTHREADS;
    for (int idx = gt; idx < 2048 * 128; idx += NT) {
        const int ch0 = (idx & 127) * 8, t0 = (idx >> 7) * 16;
        float w[4][8], bb[8], h[3][8];
#pragma unroll
        for (int e = 0; e < 8; ++e) { bb[e] = cb[ch0 + e];
#pragma unroll
            for (int k = 0; k < 4; ++k) w[k][e] = cw[k * 1024 + ch0 + e]; }
        const bool first = (t0 & 8191) == 0;
#pragma unroll
        for (int k = 0; k < 3; ++k) { u32x4 xw = {0u, 0u, 0u, 0u};
            if (!first) xw = *(const u32x4*)(XPRE + (size_t)(t0 - 3 + k) * 1024 + ch0);
            h[k][0] = bf_lo(xw.x); h[k][1] = bf_hi(xw.x); h[k][2] = bf_lo(xw.y); h[k][3] = bf_hi(xw.y); h[k][4] = bf_lo(xw.z); h[k][5] = bf_hi(xw.z); h[k][6] = bf_lo(xw.w); h[k][7] = bf_hi(xw.w); }
        u32x4 xrow[16];
#pragma unroll
        for (int i = 0; i < 16; ++i) xrow[i] = *(const u32x4*)(XPRE + (size_t)(t0 + i) * 1024 + ch0);
#pragma unroll
        for (int i = 0; i < 16; ++i) {
            const u32x4 xw = xrow[i];
            float x[8] = {bf_lo(xw.x), bf_hi(xw.x), bf_lo(xw.y), bf_hi(xw.y), bf_lo(xw.z), bf_hi(xw.z), bf_lo(xw.w), bf_hi(xw.w)};
            float y[8];
#pragma unroll
            for (int e = 0; e < 8; ++e) { y[e] = bb[e] + w[0][e] * h[0][e] + w[1][e] * h[1][e] + w[2][e] * h[2][e] + w[3][e] * x[e]; h[0][e] = h[1][e]; h[1][e] = h[2][e]; h[2][e] = x[e]; }
            u32x4 o; o.x = pk_bf16(y[0], y[1]); o.y = pk_bf16(y[2], y[3]); o.z = pk_bf16(y[4], y[5]); o.w = pk_bf16(y[6], y[7]);
            *(u32x4*)(XB + (size_t)(t0 + i) * 1024 + ch0) = o; }
    }
}

template <bool FINAL>
__device__ __forceinline__ void scan_chunk_phase(const bf16_t* A, const bf16_t* U, const bf16_t* Y, float* SUMP, float* SUMH, const float* CARRY, bf16_t* HY, const int tid, const int bx, const int G) {
    const int gt = bx * NTHREADS + tid, NT = G * NTHREADS;
    for (int idx = gt; idx < 4 * 128 * 512; idx += NT) {
        const int chp = idx & 511, bk = idx >> 9;
        const size_t t0 = (size_t)bk * 64;
        float h0 = 0.f, h1 = 0.f, p0 = 1.f, p1 = 1.f;
        if (FINAL) { const f32x2 cv = *(const f32x2*)(CARRY + (size_t)bk * 1024 + 2 * chp); h0 = cv.x; h1 = cv.y; }
#pragma unroll 1
        for (int i0 = 0; i0 < 64; i0 += 16) {
            unsigned awv[16], uwv[16], ywv[16];
#pragma unroll
            for (int q = 0; q < 16; ++q) { const size_t o = (t0 + i0 + q) * 1024 + 2 * chp; awv[q] = *(const unsigned*)(A + o); uwv[q] = *(const unsigned*)(U + o); ywv[q] = FINAL ? *(const unsigned*)(Y + o) : 0u; }
#pragma unroll
            for (int q = 0; q < 16; ++q) { const size_t o = (t0 + i0 + q) * 1024 + 2 * chp; const f32x2 a = {1.f - bf_lo(awv[q]), 1.f - bf_hi(awv[q])};
                h0 = a.x * h0 + bf_lo(uwv[q]); h1 = a.y * h1 + bf_hi(uwv[q]);
                if (FINAL) *(unsigned*)(HY + o) = pk_bf16(h0 * bf_lo(ywv[q]), h1 * bf_hi(ywv[q]));
                else { p0 *= a.x; p1 *= a.y; } } }
        if (!FINAL) { *(f32x2*)(SUMP + (size_t)bk * 1024 + 2 * chp) = (f32x2){p0, p1}; *(f32x2*)(SUMH + (size_t)bk * 1024 + 2 * chp) = (f32x2){h0, h1}; }
    }
}
__device__ __forceinline__ void scan_carry_phase(const float* SUMP, const float* SUMH, float* CARRY, LAS unsigned char* lds, const int tid, const int bx) {
    if (bx >= 64) return;
    const int seg = tid >> 6, chl = tid & 63, b = bx >> 4, ch = (bx & 15) * 64 + chl;
    float pv[16], hv[16];
#pragma unroll
    for (int q = 0; q < 16; ++q) { const size_t o = (size_t)(b * 128 + seg * 16 + q) * 1024 + ch; pv[q] = SUMP[o]; hv[q] = SUMH[o]; }
    float Pc = 1.f, Hc = 0.f;
#pragma unroll
    for (int q = 0; q < 16; ++q) { Hc = pv[q] * Hc + hv[q]; Pc *= pv[q]; }
    LAS float* ex = (LAS float*)lds;
    ex[seg * 64 + chl] = Pc; ex[512 + seg * 64 + chl] = Hc;
    __syncthreads();
    float h = 0.f;
    for (int sgi = 0; sgi < seg; ++sgi) h = ex[sgi * 64 + chl] * h + ex[512 + sgi * 64 + chl];
#pragma unroll
    for (int q = 0; q < 16; ++q) { const size_t o = (size_t)(b * 128 + seg * 16 + q) * 1024 + ch; CARRY[o] = h; h = pv[q] * h + hv[q]; }
}

__device__ __forceinline__ void cmp_w2_phase(const bf16_t* MID, const float* w2k, const float* w2v, bf16_t* KC, bf16_t* VC, const bf16_t* KS, unsigned* KMAX, const int tid, const int bx, const int G) {
    const int gt = bx * NTHREADS + tid, NT = G * NTHREADS;
    for (int r = gt; r < 16 * SEQ; r += NT) {
        const u32x4* kp = (const u32x4*)(KS + (size_t)r * 64); float n2 = 0.f;
#pragma unroll
        for (int q = 0; q < 8; ++q) { const u32x4 w = kp[q];
            n2 += (bf_lo(w.x) * bf_lo(w.x) + bf_hi(w.x) * bf_hi(w.x)) + (bf_lo(w.y) * bf_lo(w.y) + bf_hi(w.y) * bf_hi(w.y));
            n2 += (bf_lo(w.z) * bf_lo(w.z) + bf_hi(w.z) * bf_hi(w.z)) + (bf_lo(w.w) * bf_lo(w.w) + bf_hi(w.w) * bf_hi(w.w)); }
#pragma unroll
        for (int o = 1; o < 64; o <<= 1) n2 = fmaxf(n2, shx(n2, o, tid & 63));
        if ((tid & 63) == 0) atomicMax(KMAX + (r >> 13), __builtin_bit_cast(unsigned, n2));
    }
    for (int idx = gt; idx < 2 * 8192 * 64; idx += NT) {
        const int which = idx >> 19, rem = idx & ((1 << 19) - 1), row = rem >> 6, n = rem & 63;
        const bf16_t* mid = MID + (size_t)which * 8192 * 64 + (size_t)row * 64; const float* w2 = which ? w2v : w2k;
        float s = 0.f;
#pragma unroll
        for (int k8 = 0; k8 < 8; ++k8) { const u32x4 mw = *(const u32x4*)(mid + 8 * k8);
            const float mv[8] = {bf_lo(mw.x), bf_hi(mw.x), bf_lo(mw.y), bf_hi(mw.y), bf_lo(mw.z), bf_hi(mw.z), bf_lo(mw.w), bf_hi(mw.w)};
#pragma unroll
            for (int e = 0; e < 8; ++e) s += mv[e] * w2[(8 * k8 + e) * 64 + n]; }
        const bf16_t o = (bf16_t)(pk_bf16(s, 0.f) & 0xffff);
        if (which == 0) KC[(size_t)row * 64 + n] = o;
        else { const int bg = row >> 9, j = row & 511; VC[(size_t)(bg * 16 + (j >> 5)) * 2048 + n * 32 + vslot(j & 31)] = o; }
    }
}

__device__ __forceinline__ int get_tid(int wave_s) {
    int lane; asm volatile("v_mbcnt_lo_u32_b32 %0, -1, 0\n\tv_mbcnt_hi_u32_b32 %0, -1, %0" : "=v"(lane));
    return wave_s * 64 + lane;
}
__device__ __forceinline__ void grid_barrier(unsigned* ctr, unsigned target, int tid) {
    __syncthreads();
    if (tid == 0) {
        __hip_atomic_fetch_add(ctr, 1u, __ATOMIC_RELEASE, __HIP_MEMORY_SCOPE_AGENT);
        while (__hip_atomic_load(ctr, __ATOMIC_RELAXED, __HIP_MEMORY_SCOPE_AGENT) < target) __builtin_amdgcn_s_sleep(1);
        __builtin_amdgcn_fence(__ATOMIC_ACQUIRE, "agent");
    }
    __syncthreads();
}
typedef const __attribute__((address_space(4))) Params* ParamsPtr;
__global__ void __launch_bounds__(NTHREADS, 2) mk_fwd(Params P) {
    extern __shared__ __attribute__((aligned(16))) unsigned char lds_raw[];
    LAS unsigned char* lds = (LAS unsigned char*)lds_raw;
    const int wave_s = __builtin_amdgcn_readfirstlane((int)threadIdx.x >> 6);
    const int lo = P.ph_lo, hi = P.ph_hi;
    if (lo < 0) cg::this_grid().sync();
    int ph = 0; unsigned nbar = 0;
#define PHASE_BEGIN if (ph >= lo && ph < hi) { ParamsPtr Pp = (ParamsPtr)__builtin_amdgcn_kernarg_segment_ptr(); asm volatile("" : "+s"(Pp)); \
        unsigned char* const ws = Pp->ws; int G = gridDim.x, bx = blockIdx.x; asm volatile("" : "+s"(G), "+s"(bx)); const int tid = get_tid(wave_s); (void)G; (void)bx; (void)tid;
#define PHASE_END   if (ph + 1 < hi) { ++nbar; grid_barrier((unsigned*)(ws + WS_BAR), nbar * (unsigned)G, get_tid(wave_s)); } } ++ph;
#define HB_   ((bf16_t*)(ws + WS_HB))
#define XB_   ((bf16_t*)(ws + WS_XB))
#define PART_ ((float*)(ws + WS_PART))
#define XPRE_ ((bf16_t*)(ws + WS_XPRE))
#define BIG_  ((bf16_t*)(ws + WS_BIG))

    PHASE_BEGIN prep_phase(Pp, lds, tid, bx, G); __syncthreads(); PHASE_END

#pragma unroll 1
    for (int L = 0; L < 4; ++L) {
        const int j = L >> 1; const bool nsa = L & 1;
#pragma unroll 1
        for (int sub = 0; sub < 2; ++sub) {
            if (sub == 0 && !nsa) {
                PHASE_BEGIN { pg8::Gemm g{HB_, (const bf16_t*)(ws + W_RGIN) + (size_t)j * 2048 * 1024, 1024, 1024, 1024, 1, 0}; pg8::StaticOrder S; S.init(T_TOK, 2048, G, bx);
                    pg8::EpiRgIn E{ws}; pg8::gemm_phase(lds, tid, g, S, E); } PHASE_END
                PHASE_BEGIN conv_phase(XPRE_, Pp->in[5] + (size_t)j * 4096, Pp->in[6] + (size_t)j * 1024, XB_, tid, bx, G); PHASE_END
                PHASE_BEGIN { pg8::Gemm g{XB_, (const bf16_t*)(ws + W_RGGATE) + (size_t)j * 2048 * 256, 1024, 256, 256, 2, 256}; pg8::StaticOrder S; S.init(T_TOK, 2048, G, bx);
                    pg8::EpiGates E{ws, Pp->in[8] + (size_t)j * 1024, Pp->in[10] + (size_t)j * 1024, Pp->in[11] + (size_t)j * 1024};
                    pg8::gemm_phase(lds, tid, g, S, E); } PHASE_END
                PHASE_BEGIN scan_carry_phase((const float*)(ws + WS_SUMP), (const float*)(ws + WS_SUMH), (float*)(ws + WS_CARRY), lds, tid, bx); __syncthreads(); PHASE_END
                PHASE_BEGIN scan_chunk_phase<true>((const bf16_t*)(ws + WS_A), (const bf16_t*)(ws + WS_U), (const bf16_t*)(ws + WS_Y), nullptr, nullptr, (const float*)(ws + WS_CARRY), XPRE_, tid, bx, G); PHASE_END
            } else if (sub == 0) {
                PHASE_BEGIN { pg8::Gemm g{HB_, (const bf16_t*)(ws + W_NSAIN + (size_t)j * NSAIN_BYTES), 1024, 1024, 1024, 1, 0}; pg8::StaticOrder S; S.init(T_TOK, NSA_NPAD, G, bx);
                    pg8::EpiNsaIn E{ws, Pp->in[14] + (size_t)j * 48};
                    pg8::gemm_phase(lds, tid, g, S, E); } PHASE_END
                PHASE_BEGIN {
#pragma unroll 1
                    for (int kv = 0; kv < 2; ++kv) { pg8::Gemm g{(const bf16_t*)(ws + WS_KV) + (size_t)kv * KV_ELEMS, (const bf16_t*)(ws + W_W1) + (size_t)(j * 2 + kv) * 256 * 2048, 1024, 2048, 2048, 1, 0};
                        pg8::StaticOrder S; S.init(8192, 256, G, (bx + kv * (G / 2)) % G);
                        pg8::EpiCmp E{(bf16_t*)(ws + WS_MID) + (size_t)kv * 8192 * 64, (const float*)(ws + WS_C1) + (j * 2 + kv) * 64};
                        pg8::gemm_phase(lds, tid, g, S, E); } } PHASE_END
                PHASE_BEGIN cmp_w2_phase((const bf16_t*)(ws + WS_MID), Pp->in[18] + (size_t)j * 4096, Pp->in[20] + (size_t)j * 4096, (bf16_t*)(ws + WS_KC), (bf16_t*)(ws + WS_VC), (const bf16_t*)(ws + WS_KV) + 2 * KV_ELEMS, (unsigned*)(ws + WS_KMAX), tid, bx, G); PHASE_END
                PHASE_BEGIN {
                    const int nrounds = (2048 + G - 1) / G;
#pragma unroll 1
                    for (int r = 0; r < nrounds; ++r) { const int idx = r * G + ((r & 1) ? (G - 1 - bx) : bx);
                        if (idx < 2048) att::attn_unit(lds, idx & 15, 127 - (idx >> 4), (const bf16_t*)(ws + WS_Q), (const bf16_t*)(ws + WS_KV), (const bf16_t*)(ws + WS_KC), (const bf16_t*)(ws + WS_VC), (const float*)(ws + WS_GATE), XPRE_, (const unsigned*)(ws + WS_KMAX), tid); }
                    __syncthreads(); } PHASE_END
            } else {
                PHASE_BEGIN { pg8::Gemm g{HB_, (const bf16_t*)(ws + W_UP) + (size_t)L * 4096 * 1024, 1024, 1024, 1024, 1, 0}; pg8::StaticOrder S; S.init(T_TOK, 4096, G, bx, (G == 256) ? 1 : 0);
                    pg8::EpiRelu2 E{ws}; pg8::gemm_phase(lds, tid, g, S, E); } PHASE_END
            }
            PHASE_BEGIN { const bf16_t* Bt = (sub == 1) ? (const bf16_t*)(ws + W_DN) + (size_t)L * 1024 * 4096 : (nsa ? (const bf16_t*)(ws + W_NSAOUT) : (const bf16_t*)(ws + W_RGOUT)) + (size_t)j * 1024 * 1024;
                const int K = (sub == 1) ? 4096 : 1024;
                pg8::Gemm g{(sub == 1) ? BIG_ : XPRE_, Bt, K, K, K, 1, 0}; pg8::StaticOrder S; S.init(T_TOK, 1024, G, bx);
                pg8::EpiResid E{ws}; pg8::gemm_phase(lds, tid, g, S, E); } PHASE_END
        }
    }
    PHASE_BEGIN final_norm_phase(HB_, Pp->in[3], Pp->out, tid, bx, G); PHASE_END
#undef PHASE_BEGIN
#undef PHASE_END
}
constexpr int NPHASES = 1 + 2 * 8 + 2 * 7 + 1;

extern "C" void kernel_launch(void* const* d_in, const int* in_sizes, int n_in, void* d_out, int out_size, void* d_ws, size_t ws_size, hipStream_t stream) {
    static int grid = 0;
    if (grid == 0) {
        if (n_in != 24 || out_size != T_TOK * DM || ws_size < WS_END) { fprintf(stderr, "kernel_launch: unexpected shapes (n_in %d out %d ws %zu)\n", n_in, out_size, ws_size); grid = -1; return; }
        int dev = 0, cus = 0, per_cu = 0;
        hipGetDevice(&dev); hipDeviceGetAttribute(&cus, hipDeviceAttributeMultiprocessorCount, dev);
        if (hipFuncSetAttribute((const void*)mk_fwd, hipFuncAttributeMaxDynamicSharedMemorySize, LDS_BYTES) != hipSuccess) { fprintf(stderr, "kernel_launch: hipFuncSetAttribute failed\n"); grid = -1; return; }
        if (hipOccupancyMaxActiveBlocksPerMultiprocessor(&per_cu, (const void*)mk_fwd, NTHREADS, LDS_BYTES) != hipSuccess || per_cu < 1) { fprintf(stderr, "kernel_launch: occupancy query says %d\n", per_cu); per_cu = 1; }
        (void)hipGetLastError();
        grid = cus;
    }
    if (grid < 0) return;
    if (hipMemsetAsync((char*)d_ws + WS_BAR, 0, 256, stream) != hipSuccess) { fprintf(stderr, "kernel_launch: memset failed\n"); return; }
    Params p{};
    for (int i = 0; i < 24; ++i) p.in[i] = (const float*)d_in[i];
    p.out = (float*)d_out; p.ws = (unsigned char*)d_ws;
#if MK_MULTI
    for (int ph = 0; ph < NPHASES; ++ph) { p.ph_lo = ph; p.ph_hi = ph + 1; hipLaunchKernelGGL(mk_fwd, dim3(grid), dim3(NTHREADS), LDS_BYTES, stream, p); }
#else
    p.ph_lo = 0; p.ph_hi = NPHASES;
    void* args[] = {&p};
    hipError_t e = hipLaunchCooperativeKernel((const void*)mk_fwd, dim3(grid), dim3(NTHREADS), args, LDS_BYTES, stream);
    if (e != hipSuccess) fprintf(stderr, "cooperative launch failed: %s (grid %d)\n", hipGetErrorString(e), grid);
#endif
}
```
